# Optimizing an MI355X kernel written in HIP

```python
import math
import jax, jax.numpy as jnp
from jax import lax
import numpy as np

D_MODEL = 4096
BATCH = 8
SEQ = 2048
DEPTH = 2

CHUNK = 64
N_GROUPS = 4
GROUP_W = D_MODEL // N_GROUPS
D_MIX = N_GROUPS * GROUP_W
SGU_CHUNK = 128
SGU_HEADS = 8
CONV_WIDTH = 31
CONV_GROUPS = 8
RET_HEADS = 4
RET_HEAD_DIM = GROUP_W // RET_HEADS
MEM_LEN = 256
MEM_HEADS = 4
MEM_HEAD_DIM = GROUP_W // MEM_HEADS
ROPE_BASE = 10000.0
EPS = 1e-6
N_IN_SLICES = 12
W_IN_COLS = N_IN_SLICES * GROUP_W

kernel_name = "hybrid_sgu_conformer_retention_memory_block"


def rms_norm(x, g):
    xf = x.astype(jnp.float32)
    y = xf * lax.rsqrt(jnp.mean(xf * xf, axis=-1, keepdims=True) + EPS)
    return (y * g.astype(jnp.float32)).astype(x.dtype)


def group_layer_norm(x, n_groups, g, b):
    shp = x.shape
    xf = x.astype(jnp.float32).reshape(shp[:-1] + (n_groups, shp[-1] // n_groups))
    mu = jnp.mean(xf, axis=-1, keepdims=True)
    var = jnp.mean(jnp.square(xf - mu), axis=-1, keepdims=True)
    y = ((xf - mu) * lax.rsqrt(var + EPS)).reshape(shp)
    return (y * g.astype(jnp.float32) + b.astype(jnp.float32)).astype(x.dtype)


def sgu_spatial_mix(v, w_s, b_s):
    bsz, s_len, _ = v.shape
    n = s_len // SGU_CHUNK
    vb = v.reshape(bsz, n, SGU_CHUNK, SGU_HEADS, GROUP_W // SGU_HEADS)
    mask = jnp.tril(jnp.ones((SGU_CHUNK, SGU_CHUNK), v.dtype))
    out = jnp.einsum('gts,bnsgc->bntgc', w_s * mask, vb) + b_s.T[None, None, :, :, None]
    return out.reshape(bsz, s_len, GROUP_W)


def causal_depthwise_conv(x, w, b):
    y = lax.conv_general_dilated(
        x, w[:, None, :], window_strides=(1,), padding=[(CONV_WIDTH - 1, 0)],
        dimension_numbers=('NWC', 'WIO', 'NWC'), feature_group_count=x.shape[-1])
    return y + b


def rotary(x, cos, sin):
    x1, x2 = jnp.split(x, 2, axis=-1)
    return jnp.concatenate([x1 * cos - x2 * sin, x2 * cos + x1 * sin], axis=-1)


def retention_chunkwise(q, k, v):
    bsz, s_len, n_h, d = q.shape
    n = s_len // CHUNK
    dt = v.dtype
    log_g = jnp.log(1.0 - jnp.power(2.0, -5.0 - jnp.arange(n_h, dtype=jnp.float32)))
    t = jnp.arange(CHUNK, dtype=jnp.float32)
    diff = t[:, None] - t[None, :]
    intra_decay = jnp.where(diff >= 0, jnp.exp(log_g[:, None, None] * jnp.maximum(diff, 0.0)), 0.0).astype(dt)
    k_decay = jnp.exp(log_g[:, None] * (CHUNK - 1 - t)[None, :]).astype(dt)
    q_decay = jnp.exp(log_g[:, None] * (t + 1)[None, :]).astype(dt)
    chunk_decay = jnp.exp(log_g * CHUNK).astype(dt)
    qc = q.reshape(bsz, n, CHUNK, n_h, d)
    kc = k.reshape(bsz, n, CHUNK, n_h, d)
    vc = v.reshape(bsz, n, CHUNK, n_h, d)
    scores = jnp.einsum('bnthd,bnshd->bnhts', qc, kc) * intra_decay
    intra = jnp.einsum('bnhts,bnshe->bnthe', scores, vc)
    chunk_kv = jnp.einsum('bnshd,hs,bnshe->bnhde', kc, k_decay, vc)

    def step(state, kv):
        return chunk_decay[None, :, None, None] * state + kv, state

    _, prev = lax.scan(step, jnp.zeros((bsz, n_h, d, d), dt), jnp.moveaxis(chunk_kv, 1, 0))
    prev = jnp.moveaxis(prev, 0, 1)
    cross = jnp.einsum('bnthd,ht,bnhde->bnthe', qc, q_decay, prev)
    return (intra + cross).reshape(bsz, s_len, n_h, d)


def memory_attention(q, mem_n, w_mem_kv):
    bsz, m_len, _ = mem_n.shape
    kv = jnp.einsum('bmd,de->bme', mem_n, w_mem_kv)
    k_m, v_m = jnp.split(kv, 2, axis=-1)
    k_m = k_m.reshape(bsz, m_len, MEM_HEADS, MEM_HEAD_DIM)
    v_m = v_m.reshape(bsz, m_len, MEM_HEADS, MEM_HEAD_DIM)
    s = jnp.einsum('bshd,bmhd->bhsm', q, k_m).astype(jnp.float32) * (MEM_HEAD_DIM ** -0.5)
    p = jax.nn.softmax(s, axis=-1).astype(v_m.dtype)
    return jnp.einsum('bhsm,bmhd->bshd', p, v_m).reshape(q.shape[0], q.shape[1], GROUP_W)


def setup_inputs(seed: int = 0) -> dict:
    key = jax.random.key(seed)
    ks = jax.random.split(key, 24)
    f32 = jnp.float32
    nrm = lambda k, shp, sc: jax.random.normal(k, shp, f32) * sc
    x = nrm(ks[0], (BATCH, SEQ, D_MODEL), 1.0)
    mem = nrm(ks[1], (BATCH, MEM_LEN, D_MODEL), 1.0)
    start = jax.random.randint(ks[2], (BATCH, 1), 0, 4096, dtype=jnp.int32)
    positions = (start + jnp.arange(SEQ, dtype=jnp.int32)[None, :]).astype(jnp.int32)
    return {
        "x": x,
        "mem": mem,
        "positions": positions,
        "norm_g": 1.0 + nrm(ks[3], (DEPTH, D_MODEL), 0.02),
        "w_in": nrm(ks[4], (DEPTH, D_MODEL, W_IN_COLS), D_MODEL ** -0.5),
        "sgu_norm_g": 1.0 + nrm(ks[5], (DEPTH, GROUP_W), 0.02),
        "sgu_norm_b": nrm(ks[6], (DEPTH, GROUP_W), 0.02),
        "sgu_w": nrm(ks[7], (DEPTH, SGU_HEADS, SGU_CHUNK, SGU_CHUNK), 0.5 * SGU_CHUNK ** -0.5),
        "sgu_b": 1.0 + nrm(ks[8], (DEPTH, SGU_HEADS, SGU_CHUNK), 0.02),
        "conv_w": nrm(ks[9], (DEPTH, CONV_WIDTH, GROUP_W), CONV_WIDTH ** -0.5),
        "conv_b": nrm(ks[10], (DEPTH, GROUP_W), 0.02),
        "conv_norm_g": 1.0 + nrm(ks[11], (DEPTH, GROUP_W), 0.02),
        "conv_norm_b": nrm(ks[12], (DEPTH, GROUP_W), 0.02),
        "ret_norm_g": 1.0 + nrm(ks[13], (DEPTH, GROUP_W), 0.02),
        "ret_norm_b": nrm(ks[14], (DEPTH, GROUP_W), 0.02),
        "mem_norm_g": 1.0 + nrm(ks[15], (DEPTH, D_MODEL), 0.02),
        "w_mem_kv": nrm(ks[16], (DEPTH, D_MODEL, 2 * GROUP_W), D_MODEL ** -0.5),
        "w_out": nrm(ks[17], (DEPTH, D_MIX, D_MODEL), D_MIX ** -0.5),
        "final_norm_g": 1.0 + nrm(ks[18], (D_MODEL,), 0.02),
    }


def reference(x, mem, positions, norm_g, w_in, sgu_norm_g, sgu_norm_b, sgu_w, sgu_b,
              conv_w, conv_b, conv_norm_g, conv_norm_b, ret_norm_g, ret_norm_b,
              mem_norm_g, w_mem_kv, w_out, final_norm_g):
    bsz, s_len, _ = x.shape
    half = RET_HEAD_DIM // 2
    inv_freq = jnp.power(ROPE_BASE, -jnp.arange(half, dtype=jnp.float32) / half)
    ang = positions.astype(jnp.float32)[..., None] * inv_freq
    cos = jnp.cos(ang)[:, :, None, :].astype(x.dtype)
    sin = jnp.sin(ang)[:, :, None, :].astype(x.dtype)

    for l in range(DEPTH):
        h = rms_norm(x, norm_g[l])
        proj = jnp.einsum('bsd,de->bse', h, w_in[l])
        (a_u, a_v, a_g, b_a, b_b, b_g,
         c_q, c_k, c_v, c_g, m_q, m_g) = jnp.split(proj, N_IN_SLICES, axis=-1)

        a_v = group_layer_norm(a_v, 1, sgu_norm_g[l], sgu_norm_b[l])
        y_a = a_u * sgu_spatial_mix(a_v, sgu_w[l], sgu_b[l]) * jax.nn.silu(a_g)

        glu = b_a * jax.nn.sigmoid(b_b)
        cv = causal_depthwise_conv(glu, conv_w[l], conv_b[l])
        cv = group_layer_norm(cv, CONV_GROUPS, conv_norm_g[l], conv_norm_b[l])
        y_b = jax.nn.silu(cv) * jax.nn.silu(b_g)

        q = rotary(c_q.reshape(bsz, s_len, RET_HEADS, RET_HEAD_DIM), cos, sin)
        k = rotary(c_k.reshape(bsz, s_len, RET_HEADS, RET_HEAD_DIM), cos, sin) * (RET_HEAD_DIM ** -0.5)
        v = c_v.reshape(bsz, s_len, RET_HEADS, RET_HEAD_DIM)
        r = retention_chunkwise(q, k, v).reshape(bsz, s_len, GROUP_W)
        r = group_layer_norm(r, RET_HEADS, ret_norm_g[l], ret_norm_b[l])
        y_c = r * jax.nn.silu(c_g)

        mem_n = rms_norm(mem, mem_norm_g[l])
        mq = m_q.reshape(bsz, s_len, MEM_HEADS, MEM_HEAD_DIM)
        y_m = memory_attention(mq, mem_n, w_mem_kv[l]) * jax.nn.silu(m_g)

        y = jnp.concatenate([y_a, y_b, y_c, y_m], axis=-1)
        x = x + jnp.einsum('bse,ed->bsd', y, w_out[l])

    return rms_norm(x, final_norm_g)
```

```cpp
#include <hip/hip_runtime.h>
#include <hip/hip_cooperative_groups.h>
#include <cstdio>
#include <cstdint>
namespace cg = cooperative_groups;

#define DI __device__ __forceinline__
#define LAS __attribute__((address_space(3)))
typedef unsigned short bf16_t;
typedef short bf16x8 __attribute__((ext_vector_type(8)));
typedef short s16x4 __attribute__((ext_vector_type(4)));
typedef float f32x4 __attribute__((ext_vector_type(4)));
typedef float f32x2 __attribute__((ext_vector_type(2)));
typedef float f32x16 __attribute__((ext_vector_type(16)));
typedef unsigned u32x4 __attribute__((ext_vector_type(4)));
typedef unsigned u32x2 __attribute__((ext_vector_type(2)));

namespace pg8 {
constexpr int BM = 256, BK = 64, HALF = 128, HTB = HALF * BK * 2, STAGE_BYTES = 8 * HTB, NXCD = 8, WGM = 8;
__host__ __device__ __forceinline__ int lds_byte(int r, int c) { const int st = (r >> 4) * 2 + (c >> 5), rr = r & 15, cc = c & 31, ob = rr * 64 + cc * 2; return st * 1024 + (ob ^ (((ob >> 9) & 1) << 5)); }
__host__ __device__ __forceinline__ void stage_rc(int b, int& R, int& C) { const int st = b / 1024, sb = b % 1024, swz = sb ^ (((sb >> 9) & 1) << 5); R = (st >> 1) * 16 + swz / 64; C = (st & 1) * 32 + (swz % 64) / 2; }
__host__ __device__ __forceinline__ int perm32(int rho) { const int n = rho >> 4, i = rho & 15; return 8 * (i >> 2) + 4 * n + (i & 3); }
struct Unit { int pm, pn; };
struct Gemm { const bf16_t* A; const bf16_t* Bt; int M, N, K; };
struct StaticOrder {
    int nM, nN, nwg, G, c;
    __host__ __device__ void init(int M, int N, int G_, int c_) { nM = M / BM; nN = N / BM; nwg = nM * nN; G = G_; c = c_; }
    __host__ __device__ bool next(int i, Unit& u) const {
        const long L = (long)i * G + c; if (L >= nwg) return false;
        int wgid = (int)L; { const int q = nwg / NXCD, r = nwg % NXCD, xcd = wgid % NXCD, off = wgid / NXCD; wgid = (xcd < r ? xcd * (q + 1) : r * (q + 1) + (xcd - r) * q) + off; }
        const int nig = WGM * nN, gid = wgid / nig, fm = gid * WGM, gsz = (nM - fm) < WGM ? (nM - fm) : WGM;
        u.pm = fm + ((wgid % nig) % gsz); u.pn = (wgid % nig) / gsz; return true;
    }
    __device__ __forceinline__ void a_ready(const Unit&) const {}
    __device__ __forceinline__ void done(const Unit&) const {}
};
struct SubOrder {
    int nNv, nwg, split, off0, off1, c, G, mode;
    __device__ __forceinline__ bool next(int i, Unit& u) const {
        int L;
        if (mode == 0) { L = i * G + c; if (L >= nwg) return false; }
        else if (c >= 32) { if (i < 8) L = i * 224 + (c - 32); else if (i == 8 && c < 96) L = 1984 + (c - 32); else return false; }
        else { if (i < 6) L = 1792 + i * 32 + c; else return false; }
        int wgid = L; { const int q = nwg / NXCD, xcd = wgid % NXCD, off = wgid / NXCD; wgid = xcd * q + off; }
        const int nig = WGM * nNv, gid = wgid / nig; const int pv = (wgid % nig) / WGM;
        u.pm = gid * WGM + ((wgid % nig) % WGM); u.pn = pv < split ? pv + off0 : pv + off1; return true;
    }
    __device__ __forceinline__ void a_ready(const Unit&) const {}
    __device__ __forceinline__ void done(const Unit&) const {}
};
__device__ __forceinline__ unsigned cvt_pk_bf16(float lo, float hi) { unsigned r; asm volatile("v_cvt_pk_bf16_f32 %0, %1, %2" : "=v"(r) : "v"(lo), "v"(hi)); return r; }

struct EpiProj {
    static constexpr bool PERM = true, AFTER_DRAIN = false;
    bf16_t* O; int ldc; const float* rss; float invk, eps; int mode; const float* ctab; const float* stab; float* avstat;
    __device__ __forceinline__ void operator()(const f32x4 (&acc)[2][2][4][2], const Unit& u, int wr, int wc, int fr, int fq) const {
        const int row0 = u.pm * BM + wr * 64 + fr; const int col0 = u.pn * BM + wc * 32 + 8 * fq;
        const bool rot = mode == 1 && u.pn >= 24 && u.pn < 32, stat = mode == 1 && u.pn >= 4 && u.pn < 8;
        float lg2 = 0.f, kmul = 1.f;
        if (rot) { const int hd = (u.pn - 24) & 3; lg2 = log2f(1.f - exp2f(-5.f - (float)hd)); if (u.pn >= 28) { lg2 = -lg2; kmul = 0.0625f; } }
#pragma unroll
        for (int ai = 0; ai < 2; ++ai)
#pragma unroll
            for (int m = 0; m < 4; ++m) { const int row = row0 + ai * HALF + m * 16; bf16_t* rowp = O + (size_t)row * ldc + col0;
                float sc = 1.f; if (rss) sc = rsqrtf(rss[row] * invk + eps);
                f32x4 v[2][2];
#pragma unroll
                for (int bj = 0; bj < 2; ++bj)
#pragma unroll
                    for (int n = 0; n < 2; ++n) v[bj][n] = acc[ai][bj][m][n] * sc;
                if (rot) { const float f = exp2f((float)(row & 63) * lg2) * kmul; const int j0 = wc * 32 + 8 * fq;
#pragma unroll
                    for (int n = 0; n < 2; ++n) { const f32x4 cs = *(const f32x4*)(ctab + (size_t)row * 128 + j0 + 4 * n), sn = *(const f32x4*)(stab + (size_t)row * 128 + j0 + 4 * n);
                        const f32x4 x1 = v[0][n], x2 = v[1][n]; v[0][n] = (x1 * cs - x2 * sn) * f; v[1][n] = (x2 * cs + x1 * sn) * f; } }
                if (stat) { float s1 = 0.f, s2 = 0.f;
#pragma unroll
                    for (int bj = 0; bj < 2; ++bj)
#pragma unroll
                        for (int n = 0; n < 2; ++n) { const f32x4 x = v[bj][n]; s1 += (x[0] + x[1]) + (x[2] + x[3]); s2 += (x[0] * x[0] + x[1] * x[1]) + (x[2] * x[2] + x[3] * x[3]); }
                    s1 += __shfl_xor(s1, 16); s1 += __shfl_xor(s1, 32); s2 += __shfl_xor(s2, 16); s2 += __shfl_xor(s2, 32);
                    if (fq == 0) { atomicAdd(avstat + 2 * row, s1); atomicAdd(avstat + 2 * row + 1, s2); } }
#pragma unroll
                for (int bj = 0; bj < 2; ++bj) { const f32x4 v0 = v[bj][0], v1 = v[bj][1];
                    u32x4 w; w.x = cvt_pk_bf16(v0[0], v0[1]); w.y = cvt_pk_bf16(v0[2], v0[3]); w.z = cvt_pk_bf16(v1[0], v1[1]); w.w = cvt_pk_bf16(v1[2], v1[3]);
                    *(u32x4*)(rowp + bj * HALF) = w; } }
    }
};
struct EpiRes {
    static constexpr bool PERM = true, AFTER_DRAIN = false;
    const float* basef; bf16_t* xb; float* rss; int ldc;
    __device__ __forceinline__ void operator()(const f32x4 (&acc)[2][2][4][2], const Unit& u, int wr, int wc, int fr, int fq) const {
        const int col0 = u.pn * BM + wc * 32 + 8 * fq;
#pragma unroll
        for (int ai = 0; ai < 2; ++ai)
#pragma unroll
            for (int m = 0; m < 4; ++m) { const int r = u.pm * BM + ai * HALF + wr * 64 + m * 16 + fr; const size_t off = (size_t)r * ldc + col0; float ss = 0.f;
#pragma unroll
                for (int bj = 0; bj < 2; ++bj) { f32x4 b0, b1;
                    if (basef) { b0 = *(const f32x4*)(basef + off + bj * HALF); b1 = *(const f32x4*)(basef + off + bj * HALF + 4); }
                    else { const u32x4 wb = *(const u32x4*)(xb + off + bj * HALF);
                        b0 = (f32x4){__uint_as_float(wb.x << 16), __uint_as_float(wb.x & 0xffff0000u), __uint_as_float(wb.y << 16), __uint_as_float(wb.y & 0xffff0000u)};
                        b1 = (f32x4){__uint_as_float(wb.z << 16), __uint_as_float(wb.z & 0xffff0000u), __uint_as_float(wb.w << 16), __uint_as_float(wb.w & 0xffff0000u)}; }
                    const f32x4 o0 = b0 + acc[ai][bj][m][0], o1 = b1 + acc[ai][bj][m][1];
                    ss += ((o0[0] * o0[0] + o0[1] * o0[1]) + (o0[2] * o0[2] + o0[3] * o0[3])) + ((o1[0] * o1[0] + o1[1] * o1[1]) + (o1[2] * o1[2] + o1[3] * o1[3]));
                    u32x4 w; w.x = cvt_pk_bf16(o0[0], o0[1]); w.y = cvt_pk_bf16(o0[2], o0[3]); w.z = cvt_pk_bf16(o1[0], o1[1]); w.w = cvt_pk_bf16(o1[2], o1[3]);
                    *(u32x4*)(xb + off + bj * HALF) = w; }
                ss += __shfl_xor(ss, 16); ss += __shfl_xor(ss, 32);
                if (fq == 0) atomicAdd(rss + r, ss); }
    }
};

template <class Epi, class Sched, bool ALIGN_EPI = false, bool SP2 = false>
__device__ __forceinline__ void gemm_phase(LAS unsigned char* lds, const Gemm g, const Sched& S, const Epi& E) {
    int tid = threadIdx.x; asm volatile("" : "+v"(tid));
    const int wid = __builtin_amdgcn_readfirstlane(tid >> 6), lane = tid & 63, wr = wid >> 2, wc = wid & 3, fr = lane & 15, fq = lane >> 4;
    const int K = g.K, nt = K / BK;
    unsigned voffA[2], voffB[2];
#pragma unroll
    for (int i = 0; i < 2; ++i) { int R, C; stage_rc(tid * 16 + i * 8192, R, C); const int Rb = Epi::PERM ? ((R & ~31) + perm32(R & 31)) : R;
        voffA[i] = (unsigned)(R * K + C) * 2u; voffB[i] = (unsigned)(Rb * K + C) * 2u; }
    const size_t kstep = (size_t)(BK * 2);
    const size_t hstep = (size_t)HALF * K * 2;
    const size_t tstep = 2 * hstep;
    const unsigned ldsw = (unsigned)wid * 1024u;
    const int aoff = lds_byte(wr * 64 + fr, fq * 8), boff = lds_byte(wc * 32 + fr, fq * 8);
#define PG8_SA(b, h) (((b) * 2 + (h)) * HTB)
#define PG8_SB(b, h) ((4 + (b) * 2 + (h)) * HTB)
#define PG8_STAGE(bufoff, gbase, voff) do { _Pragma("unroll") for (int _i = 0; _i < 2; ++_i) \
        __builtin_amdgcn_global_load_lds((const unsigned*)((const char*)(gbase) + (voff)[_i]), (LAS unsigned*)(lds + (bufoff) + ldsw + _i * 8192), 16, 0, 0); } while (0)
#define PG8_LDA(dst, b, h) do { _Pragma("unroll") for (int m = 0; m < 4; ++m) _Pragma("unroll") for (int k = 0; k < 2; ++k) dst[m][k] = *(const LAS bf16x8*)(lds + PG8_SA(b, h) + aoff + m * 2048 + k * 1024); } while (0)
#define PG8_LDB(dst, b, h) do { _Pragma("unroll") for (int n = 0; n < 2; ++n) _Pragma("unroll") for (int k = 0; k < 2; ++k) dst[n][k] = *(const LAS bf16x8*)(lds + PG8_SB(b, h) + boff + n * 2048 + k * 1024); } while (0)
#define PG8_MMA(ai, bj, At, Bt) do { __builtin_amdgcn_s_setprio(1); _Pragma("unroll") for (int m = 0; m < 4; ++m) _Pragma("unroll") for (int n = 0; n < 2; ++n) _Pragma("unroll") for (int k = 0; k < 2; ++k) \
        acc[ai][bj][m][n] = __builtin_amdgcn_mfma_f32_16x16x32_bf16(Bt[n][k], At[m][k], acc[ai][bj][m][n], 0, 0, 0); __builtin_amdgcn_s_setprio(0); } while (0)
#define PG8_WAIT_V(n) asm volatile("s_waitcnt vmcnt(" #n ")" ::: "memory")
#define PG8_WAIT_L(n) asm volatile("s_waitcnt lgkmcnt(" #n ")" ::: "memory")
#define PG8_BAR __builtin_amdgcn_s_barrier()
#define PG8_SCHED __builtin_amdgcn_sched_barrier(0)
    Unit cur, nxt; int ui = 0;
    if (!S.next(0, cur)) return;
    f32x4 acc[2][2][4][2];
#pragma unroll
    for (int a = 0; a < 2; ++a)
#pragma unroll
        for (int b = 0; b < 2; ++b)
#pragma unroll
            for (int m = 0; m < 4; ++m)
#pragma unroll
                for (int n = 0; n < 2; ++n) acc[a][b][m][n] = (f32x4){0.f, 0.f, 0.f, 0.f};
    bf16x8 At[4][2], B0[2][2], B1[2][2];
    const char* cA = (const char*)g.A + (size_t)cur.pm * tstep; const char* cB = (const char*)g.Bt + (size_t)cur.pn * tstep;
    S.a_ready(cur);
    if constexpr (SP2) {
        PG8_STAGE(PG8_SB(0, 0), cB, voffB); PG8_STAGE(PG8_SB(0, 1), cB + hstep, voffB); PG8_STAGE(PG8_SA(0, 0), cA, voffA); PG8_STAGE(PG8_SA(0, 1), cA + hstep, voffA);
        if (wr == 1) PG8_BAR;
        PG8_WAIT_V(2); PG8_BAR;
        PG8_STAGE(PG8_SB(1, 0), cB + kstep, voffB); PG8_STAGE(PG8_SA(1, 0), cA + kstep, voffA); PG8_STAGE(PG8_SB(1, 1), cB + hstep + kstep, voffB);
        PG8_WAIT_V(6); PG8_BAR;
    } else {
        PG8_STAGE(PG8_SB(0, 0), cB, voffB); PG8_STAGE(PG8_SA(0, 0), cA, voffA); PG8_STAGE(PG8_SB(0, 1), cB + hstep, voffB); PG8_STAGE(PG8_SA(0, 1), cA + hstep, voffA);
        if (wr == 1) PG8_BAR;
        PG8_WAIT_V(4); PG8_BAR;
        PG8_STAGE(PG8_SB(1, 0), cB + kstep, voffB); PG8_STAGE(PG8_SA(1, 0), cA + kstep, voffA); PG8_STAGE(PG8_SB(1, 1), cB + hstep + kstep, voffB);
        PG8_WAIT_V(6); PG8_BAR;
    }
    for (;;) {
        const bool has_next = S.next(ui + 1, nxt);
        const char* nA = has_next ? (const char*)g.A + (size_t)nxt.pm * tstep : cA; const char* nB = has_next ? (const char*)g.Bt + (size_t)nxt.pn * tstep : cB;
        for (int t = 0; t < nt; t += 2) {
            const bool last = (t == nt - 2);
            const char* a1 = cA + (size_t)(t + 1) * kstep;
            const char* a2 = last ? nA : cA + (size_t)(t + 2) * kstep; const char* b2 = last ? nB : cB + (size_t)(t + 2) * kstep;
            const char* a3 = a2 + kstep; const char* b3 = b2 + kstep;
            if (last && has_next) S.a_ready(nxt);
            if constexpr (SP2) {
            PG8_LDB(B0, 0, 0); PG8_LDB(B1, 0, 1); PG8_SCHED; PG8_LDA(At, 0, 0); PG8_STAGE(PG8_SA(1, 1), a1 + hstep, voffA);
            PG8_WAIT_V(8); PG8_WAIT_L(0); PG8_BAR; PG8_MMA(0, 0, At, B0); PG8_MMA(0, 1, At, B1); PG8_BAR; PG8_SCHED;
            PG8_LDA(At, 0, 1); PG8_STAGE(PG8_SB(0, 0), b2, voffB); PG8_STAGE(PG8_SB(0, 1), b2 + hstep, voffB); PG8_STAGE(PG8_SA(0, 0), a2, voffA);
            PG8_WAIT_V(8); PG8_WAIT_L(0); PG8_BAR; PG8_MMA(1, 0, At, B0); PG8_MMA(1, 1, At, B1); PG8_BAR; PG8_SCHED;
            PG8_LDB(B0, 1, 0); PG8_LDB(B1, 1, 1); PG8_SCHED; PG8_LDA(At, 1, 0); PG8_STAGE(PG8_SA(0, 1), a2 + hstep, voffA);
            PG8_WAIT_V(8); PG8_WAIT_L(0); PG8_BAR; PG8_MMA(0, 0, At, B0); PG8_MMA(0, 1, At, B1); PG8_BAR; PG8_SCHED;
            PG8_LDA(At, 1, 1); PG8_STAGE(PG8_SB(1, 0), b3, voffB); PG8_STAGE(PG8_SB(1, 1), b3 + hstep, voffB); PG8_STAGE(PG8_SA(1, 0), a3, voffA);
            PG8_WAIT_V(8); PG8_WAIT_L(0); PG8_BAR; PG8_MMA(1, 0, At, B0); PG8_MMA(1, 1, At, B1); PG8_BAR; PG8_SCHED;
            } else {
            PG8_LDB(B0, 0, 0); PG8_SCHED; PG8_LDA(At, 0, 0); PG8_STAGE(PG8_SA(1, 1), a1 + hstep, voffA);
            PG8_WAIT_L(8); PG8_BAR; PG8_WAIT_L(0); PG8_MMA(0, 0, At, B0); PG8_BAR; PG8_SCHED;
            PG8_LDB(B1, 0, 1); PG8_STAGE(PG8_SB(0, 0), b2, voffB);
            PG8_BAR; PG8_WAIT_L(0); PG8_MMA(0, 1, At, B1); PG8_BAR;
            PG8_LDA(At, 0, 1); PG8_STAGE(PG8_SA(0, 0), a2, voffA);
            PG8_BAR; PG8_WAIT_L(0); PG8_MMA(1, 0, At, B0); PG8_BAR; PG8_SCHED;
            PG8_STAGE(PG8_SB(0, 1), b2 + hstep, voffB);
            PG8_WAIT_V(6); PG8_BAR; PG8_MMA(1, 1, At, B1); PG8_BAR;
            PG8_LDB(B0, 1, 0); PG8_SCHED; PG8_LDA(At, 1, 0); PG8_STAGE(PG8_SA(0, 1), a2 + hstep, voffA);
            PG8_WAIT_L(8); PG8_BAR; PG8_WAIT_L(0); PG8_MMA(0, 0, At, B0); PG8_BAR; PG8_SCHED;
            PG8_LDB(B1, 1, 1); PG8_STAGE(PG8_SB(1, 0), b3, voffB);
            PG8_BAR; PG8_WAIT_L(0); PG8_MMA(0, 1, At, B1); PG8_BAR;
            PG8_LDA(At, 1, 1); PG8_STAGE(PG8_SA(1, 0), a3, voffA);
            PG8_BAR; PG8_WAIT_L(0); PG8_MMA(1, 0, At, B0); PG8_BAR; PG8_SCHED;
            PG8_STAGE(PG8_SB(1, 1), b3 + hstep, voffB);
            PG8_WAIT_V(6); PG8_BAR; PG8_MMA(1, 1, At, B1); PG8_BAR;
            }
        }
        if constexpr (ALIGN_EPI) { if (wr == 0) PG8_BAR; }
        E(acc, cur, wr, wc, fr, fq); S.done(cur);
        if (!has_next) break;
#pragma unroll
        for (int a = 0; a < 2; ++a)
#pragma unroll
            for (int b = 0; b < 2; ++b)
#pragma unroll
                for (int m = 0; m < 4; ++m)
#pragma unroll
                    for (int n = 0; n < 2; ++n) acc[a][b][m][n] = (f32x4){0.f, 0.f, 0.f, 0.f};
        cur = nxt; cA = nA; cB = nB; ++ui;
        if constexpr (ALIGN_EPI) { if (wr == 1) PG8_BAR; }
    }
    PG8_WAIT_V(0);
    if constexpr (!ALIGN_EPI) { if (wr == 0) PG8_BAR; }
    PG8_BAR;
#undef PG8_SA
#undef PG8_SB
#undef PG8_STAGE
#undef PG8_LDA
#undef PG8_LDB
#undef PG8_MMA
#undef PG8_WAIT_V
#undef PG8_WAIT_L
#undef PG8_BAR
#undef PG8_SCHED
}
}

constexpr int DM = 4096, NB = 8, SEQ = 2048, MTOK = NB * SEQ, NPROJ = 12288, GW = 1024, MEMLEN = 256, MROWS = NB * MEMLEN, NKV = 2048, DEPTH = 2;
constexpr float EPS = 1e-6f;
constexpr int NWAVES = 8, NTHREADS = 512;
constexpr int C_AU = 0, C_AV = 1024, C_AG = 2048, C_BA = 3072, C_BB = 4096, C_BG = 5120, C_CQ = 6144, C_CK = 7168, C_CV = 8192, C_CG = 9216, C_MQ = 10240, C_MG = 11264;

constexpr size_t MiB = 1u << 20;
constexpr size_t WS_CTL = 0, CTL_ZERO_BYTES = 1 * MiB;
constexpr size_t WS_RSS1 = 64 * 1024, WS_RSS2 = 128 * 1024, WS_AVSTAT = 256 * 1024;
constexpr size_t WS_RSS0 = 1 * MiB;
constexpr size_t WS_WIN = 2 * MiB;
constexpr size_t WS_WOUT = WS_WIN + 192 * MiB;
constexpr size_t WS_WKV = WS_WOUT + 64 * MiB;
constexpr size_t WS_XB = WS_WKV + 32 * MiB;
constexpr size_t WS_PROJ = WS_XB + 128 * MiB;
constexpr size_t WS_Y = WS_PROJ + 384 * MiB;
constexpr size_t WS_MEMB = WS_Y + 128 * MiB;
constexpr size_t WS_KV = WS_MEMB + 16 * MiB;
constexpr size_t WS_COS = WS_KV + 8 * MiB;
constexpr size_t WS_SIN = WS_COS + 8 * MiB;
constexpr size_t WS_X1 = WS_SIN + 8 * MiB;
constexpr size_t WS_END = WS_X1 + 256 * MiB;

constexpr int LDS_MAIN = 163840 - 256, LDS_BYTES = 163840;

DI float bf2f(bf16_t v) { return __uint_as_float((unsigned)v << 16); }
DI float bflo(unsigned w) { return __uint_as_float(w << 16); }
DI float bfhi(unsigned w) { return __uint_as_float(w & 0xffff0000u); }
DI unsigned f2bf(float f) { unsigned u = __float_as_uint(f); return (u + 0x7fffu + ((u >> 16) & 1u)) >> 16; }
typedef __bf16 bf16v2 __attribute__((ext_vector_type(2)));
DI unsigned pk2(float lo, float hi) { f32x2 v = {lo, hi}; bf16v2 b = __builtin_convertvector(v, bf16v2); return __builtin_bit_cast(unsigned, b); }
DI float silu_f(float x) { return x * __builtin_amdgcn_rcpf(1.f + __expf(-x)); }
DI float sigm_f(float x) { return __builtin_amdgcn_rcpf(1.f + __expf(-x)); }
DI float wave_sum(float v) {
#pragma unroll
    for (int o = 1; o < 64; o <<= 1) v += __shfl_xor(v, o);
    return v;
}
DI void unpack8(const u32x4 w, float (&f)[8]) { f[0] = bflo(w.x); f[1] = bfhi(w.x); f[2] = bflo(w.y); f[3] = bfhi(w.y); f[4] = bflo(w.z); f[5] = bfhi(w.z); f[6] = bflo(w.w); f[7] = bfhi(w.w); }
DI u32x4 pack8f(const float (&f)[8]) { u32x4 w; w.x = pk2(f[0], f[1]); w.y = pk2(f[2], f[3]); w.z = pk2(f[4], f[5]); w.w = pk2(f[6], f[7]); return w; }
DI int crow(int reg, int h) { return (reg & 3) + 8 * (reg >> 2) + 4 * h; }
#define MFMA32(a, b, c) __builtin_amdgcn_mfma_f32_32x32x16_bf16((a), (b), (c), 0, 0, 0)

DI bf16x8 frag_row(const LAS bf16_t* img, int ld, int row0, int k0, int lane) { return *(const LAS bf16x8*)(img + (row0 + (lane & 31)) * ld + k0 + 8 * (lane >> 5)); }
DI bf16x8 frag_row_perm(const LAS bf16_t* img, int ld, int row0, int k0, int lane) {
    const LAS bf16_t* p = img + (row0 + (lane & 31)) * ld + k0 + 4 * (lane >> 5);
    const s16x4 lo = *(const LAS s16x4*)p, hi = *(const LAS s16x4*)(p + 8);
    return __builtin_shufflevector(lo, hi, 0, 1, 2, 3, 4, 5, 6, 7);
}
DI s16x4 tr16(const LAS bf16_t* p) { return __builtin_amdgcn_ds_read_tr16_b64_v4i16((LAS s16x4*)p); }
DI bf16x8 frag_tr(const LAS bf16_t* img, int ld, int k0, int x0, int lane) {
    const int h = lane >> 5, blk = (lane >> 4) & 1, q = (lane & 15) >> 2, p = lane & 3;
    const LAS bf16_t* a = img + (k0 + 8 * h + q) * ld + x0 + 16 * blk + 4 * p;
    const s16x4 lo = tr16(a), hi = tr16(a + 4 * ld);
    return __builtin_shufflevector(lo, hi, 0, 1, 2, 3, 4, 5, 6, 7);
}
DI bf16x8 frag_tr_perm(const LAS bf16_t* img, int ld, int k0, int x0, int lane) {
    const int h = lane >> 5, blk = (lane >> 4) & 1, q = (lane & 15) >> 2, p = lane & 3;
    const LAS bf16_t* a = img + (k0 + 4 * h + q) * ld + x0 + 16 * blk + 4 * p;
    const s16x4 lo = tr16(a), hi = tr16(a + 8 * ld);
    return __builtin_shufflevector(lo, hi, 0, 1, 2, 3, 4, 5, 6, 7);
}
template <int S> DI bf16x8 pack_acc(const f32x16& x) {
    u32x4 p; p.x = pk2(x[8 * S + 0], x[8 * S + 1]); p.y = pk2(x[8 * S + 2], x[8 * S + 3]); p.z = pk2(x[8 * S + 4], x[8 * S + 5]); p.w = pk2(x[8 * S + 6], x[8 * S + 7]);
    return __builtin_bit_cast(bf16x8, p);
}
DI f32x16 zero16() { f32x16 z;
#pragma unroll
    for (int i = 0; i < 16; ++i) z[i] = 0.f; return z; }

struct Params {
    const float* x; const float* mem; const int* pos; const float* norm_g; const float* w_in; const float* sgu_ng; const float* sgu_nb; const float* sgu_w; const float* sgu_b;
    const float* conv_w; const float* conv_b; const float* conv_ng; const float* conv_nb; const float* ret_ng; const float* ret_nb; const float* mem_ng; const float* w_kv; const float* w_out; const float* fin_g;
    float* out; unsigned char* ws;
};
typedef const __attribute__((address_space(4))) Params CParams;

DI void p0_item_load(const float* W, int N, int item, int lane, f32x4 (&v)[8]) {
    const int nblk = N / 32, kb = item / nblk, nb = item % nblk, k0 = 64 * kb, n0 = 32 * nb;
#pragma unroll
    for (int i = 0; i < 8; ++i) v[i] = *(const f32x4*)(W + (size_t)(k0 + (lane >> 3) + 8 * i) * N + n0 + 4 * (lane & 7));
}
DI void p0_item_store(const f32x4 (&v)[8], const float* gain, int K, int N, bf16_t* WT, LAS float* scr, int item, int lane) {
    const int nblk = N / 32, kb = item / nblk, nb = item % nblk, k0 = 64 * kb, n0 = 32 * nb;
#pragma unroll
    for (int i = 0; i < 8; ++i) { const int kk = (lane >> 3) + 8 * i; f32x4 x = v[i]; if (gain) x = x * gain[k0 + kk]; LAS float* d = scr + kk * 33 + 4 * (lane & 7); d[0] = x.x; d[1] = x.y; d[2] = x.z; d[3] = x.w; }
    asm volatile("s_waitcnt lgkmcnt(0)" ::: "memory");
    const int c = lane & 7;
#pragma unroll
    for (int j = 0; j < 4; ++j) { const int n = (lane >> 3) + 8 * j; const LAS float* s = scr + (8 * c) * 33 + n;
        u32x4 o; o.x = pk2(s[0 * 33], s[1 * 33]); o.y = pk2(s[2 * 33], s[3 * 33]); o.z = pk2(s[4 * 33], s[5 * 33]); o.w = pk2(s[6 * 33], s[7 * 33]);
        *(u32x4*)(WT + (size_t)(n0 + n) * K + k0 + 8 * c) = o; }
    asm volatile("s_waitcnt lgkmcnt(0)" ::: "memory");
}
DI void p0_matrix(const float* W, const float* gain, int K, int N, bf16_t* WT, LAS float* scr, int nitems, int gw, int NGW, int lane) {
    for (int it = gw; it < nitems; it += 4 * NGW) {
        const int it2 = it + NGW, it3 = it + 2 * NGW, it4 = it + 3 * NGW; const bool h2 = it2 < nitems, h3 = it3 < nitems, h4 = it4 < nitems;
        f32x4 va[8], vb[8], vc[8], vd[8];
        p0_item_load(W, N, it, lane, va);
        if (h2) p0_item_load(W, N, it2, lane, vb);
        if (h3) p0_item_load(W, N, it3, lane, vc);
        if (h4) p0_item_load(W, N, it4, lane, vd);
        p0_item_store(va, gain, K, N, WT, scr, it, lane);
        if (h2) p0_item_store(vb, gain, K, N, WT, scr, it2, lane);
        if (h3) p0_item_store(vc, gain, K, N, WT, scr, it3, lane);
        if (h4) p0_item_store(vd, gain, K, N, WT, scr, it4, lane);
    }
}
DI void convert_weights(CParams& P, int l, LAS unsigned char* lds, int gw, int NGW, int lane, int wave, int which = 7) {
    unsigned char* ws = P.ws;
    LAS float* scr = (LAS float*)(lds + wave * 16384);
    constexpr int I_IN = (DM / 64) * (NPROJ / 32), I_OUT = (DM / 64) * (DM / 32), I_KV = (DM / 64) * (NKV / 32);
    if (which & 1) p0_matrix(P.w_in + (size_t)l * DM * NPROJ, P.norm_g + l * DM, DM, NPROJ, (bf16_t*)(ws + WS_WIN) + (size_t)l * NPROJ * DM, scr, I_IN, gw, NGW, lane);
    if (which & 2) p0_matrix(P.w_out + (size_t)l * DM * DM, nullptr, DM, DM, (bf16_t*)(ws + WS_WOUT) + (size_t)l * DM * DM, scr, I_OUT, gw, NGW, lane);
    if (which & 4) p0_matrix(P.w_kv + (size_t)l * DM * NKV, P.mem_ng + l * DM, DM, NKV, (bf16_t*)(ws + WS_WKV) + (size_t)l * NKV * DM, scr, I_KV, gw, NGW, lane);
}
DI void prologue(CParams& P, LAS unsigned char* lds, int vcu, int G, int tid, int lane, int wave) {
    unsigned char* ws = P.ws;
    const int gw = vcu * NWAVES + wave, NGW = G * NWAVES;
    convert_weights(P, 0, lds, gw, NGW, lane, wave);
    for (int m = gw; m < MTOK + MROWS; m += NGW) {
        const bool is_x = m < MTOK; const int row = is_x ? m : m - MTOK;
        const f32x4* xr = (const f32x4*)((is_x ? P.x : P.mem) + (size_t)row * DM) + lane;
        f32x4 v[16]; float s = 0.f;
#pragma unroll
        for (int j = 0; j < 16; ++j) { v[j] = xr[64 * j]; s += (v[j].x * v[j].x + v[j].y * v[j].y) + (v[j].z * v[j].z + v[j].w * v[j].w); }
        s = wave_sum(s);
        float sc = 1.f;
        if (is_x) { if (lane == 0) ((float*)(ws + WS_RSS0))[row] = s; } else sc = rsqrtf(s * (1.f / DM) + EPS);
        u32x2* o8 = (u32x2*)((bf16_t*)(ws + (is_x ? WS_XB : WS_MEMB)) + (size_t)row * DM) + lane;
#pragma unroll
        for (int j = 0; j < 16; ++j) { u32x2 w; w.x = pk2(v[j].x * sc, v[j].y * sc); w.y = pk2(v[j].z * sc, v[j].w * sc); o8[64 * j] = w; }
    }
    float* ct = (float*)(ws + WS_COS); float* st = (float*)(ws + WS_SIN);
    for (int i = vcu * NTHREADS + tid; i < MTOK * 128; i += G * NTHREADS) {
        const int j = i & 127, row = i >> 7;
        const float inv_freq = exp2f((float)j * (-13.287712379549449f / 128.f));
        const float ang = (float)P.pos[row] * inv_freq;
        double rev = (double)ang * 0.15915494309189535; rev -= __builtin_rint(rev);
        const float rf = (float)rev;
        ct[i] = __builtin_amdgcn_cosf(rf); st[i] = __builtin_amdgcn_sinf(rf);
    }
}

DI float reduce8(const float (&v)[8], int lane) {
    const bool h5 = lane & 32, h4 = lane & 16, h3 = lane & 8;
    float a[4], b2[2];
#pragma unroll
    for (int j = 0; j < 4; ++j) { const float keep = h5 ? v[4 + j] : v[j], send = h5 ? v[j] : v[4 + j]; a[j] = keep + __shfl_xor(send, 32); }
#pragma unroll
    for (int j = 0; j < 2; ++j) { const float keep = h4 ? a[2 + j] : a[j], send = h4 ? a[j] : a[2 + j]; b2[j] = keep + __shfl_xor(send, 16); }
    const float keep = h3 ? b2[1] : b2[0], send = h3 ? b2[0] : b2[1];
    float c = keep + __shfl_xor(send, 8);
    c += __shfl_xor(c, 4); c += __shfl_xor(c, 2); c += __shfl_xor(c, 1);
    return c;
}
DI float bcast_lane(float v, int srclane) { return __uint_as_float(__builtin_amdgcn_readlane(__float_as_uint(v), srclane)); }

DI void sgu_unit(CParams& P, int l, int u, LAS unsigned char* lds, int tid_, int lane_, int wave_) {
    int tid = tid_; asm volatile("" : "+v"(tid)); const int lane = tid & 63; const int wave = __builtin_amdgcn_readfirstlane(tid >> 6);
    const int g = u & 7, n = (u >> 3) & 15, b = u >> 7;
    const bf16_t* proj = (const bf16_t*)(P.ws + WS_PROJ) + (size_t)(b * SEQ + n * 128) * NPROJ;
    bf16_t* y = (bf16_t*)(P.ws + WS_Y) + (size_t)(b * SEQ + n * 128) * DM;
    constexpr int LD = 136, LDO = 132;
    LAS bf16_t* Wm = (LAS bf16_t*)lds; LAS bf16_t* Vn = (LAS bf16_t*)(lds + 34816); LAS float* Ot = (LAS float*)(lds + 69632);
    const float* sw = P.sgu_w + ((size_t)l * 8 + g) * 128 * 128;
    f32x4 wv[8]; u32x4 vv[4]; f32x2 av[4];
#pragma unroll
    for (int i = 0; i < 8; ++i) { const int idx = tid + NTHREADS * i, t = idx >> 5, s4 = (idx & 31) * 4; wv[i] = *(const f32x4*)(sw + t * 128 + s4); }
#pragma unroll
    for (int i = 0; i < 4; ++i) { const int idx = tid + NTHREADS * i, s = idx >> 4, c8 = (idx & 15) * 8; vv[i] = *(const u32x4*)(proj + (size_t)s * NPROJ + C_AV + g * 128 + c8);
        av[i] = *(const f32x2*)((const float*)(P.ws + WS_AVSTAT) + ((size_t)l * MTOK + (size_t)(b * SEQ + n * 128 + s)) * 2); }
#pragma unroll
    for (int i = 0; i < 8; ++i) { const int idx = tid + NTHREADS * i, t = idx >> 5, s4 = (idx & 31) * 4; f32x4 w = wv[i];
        if (s4 + 0 > t) w.x = 0.f; if (s4 + 1 > t) w.y = 0.f; if (s4 + 2 > t) w.z = 0.f; if (s4 + 3 > t) w.w = 0.f;
        u32x2 o; o.x = pk2(w.x, w.y); o.y = pk2(w.z, w.w); *(LAS u32x2*)(Wm + t * LD + s4) = o; }
    const float* ng = P.sgu_ng + l * GW + g * 128; const float* nbp = P.sgu_nb + l * GW + g * 128;
#pragma unroll
    for (int i = 0; i < 4; ++i) { const int idx = tid + NTHREADS * i, s = idx >> 4, c8 = (idx & 15) * 8;
        float f[8]; unpack8(vv[i], f); const float mean = av[i].x * (1.f / GW), var = av[i].y * (1.f / GW) - mean * mean, rstd = rsqrtf(fmaxf(var, 0.f) + EPS);
        const f32x4 g0 = *(const f32x4*)(ng + c8), g1 = *(const f32x4*)(ng + c8 + 4), b0 = *(const f32x4*)(nbp + c8), b1 = *(const f32x4*)(nbp + c8 + 4);
        const float gg[8] = {g0.x, g0.y, g0.z, g0.w, g1.x, g1.y, g1.z, g1.w}, bb[8] = {b0.x, b0.y, b0.z, b0.w, b1.x, b1.y, b1.z, b1.w};
#pragma unroll
        for (int j = 0; j < 8; ++j) f[j] = (f[j] - mean) * rstd * gg[j] + bb[j];
        *(LAS u32x4*)(Vn + s * LD + c8) = pack8f(f); }
    u32x4 uu[4], gt[4];
#pragma unroll
    for (int i = 0; i < 4; ++i) { const int idx = tid + NTHREADS * i, t = idx >> 4, c8 = (idx & 15) * 8; const bf16_t* pr = proj + (size_t)t * NPROJ + g * 128 + c8;
        uu[i] = *(const u32x4*)(pr + C_AU); gt[i] = *(const u32x4*)(pr + C_AG); }
    __syncthreads();
    { const int tt = wave >> 1, ct0 = (wave & 1) * 2;
      f32x16 acc[2]; acc[0] = zero16(); acc[1] = zero16();
      for (int ks = 0; ks < 2 * (tt + 1); ++ks) { const bf16x8 a = frag_row(Wm, LD, 32 * tt, 16 * ks, lane);
#pragma unroll
          for (int j = 0; j < 2; ++j) { const bf16x8 bb = frag_tr(Vn, LD, 16 * ks, 32 * (ct0 + j), lane); acc[j] = MFMA32(a, bb, acc[j]); } }
      const int r = lane & 31, h = lane >> 5;
#pragma unroll
      for (int j = 0; j < 2; ++j)
#pragma unroll
          for (int i = 0; i < 16; ++i) Ot[(32 * tt + crow(i, h)) * LDO + 32 * (ct0 + j) + r] = acc[j][i]; }
    __syncthreads();
    const float* sb = P.sgu_b + ((size_t)l * 8 + g) * 128;
#pragma unroll
    for (int i = 0; i < 4; ++i) { const int idx = tid + NTHREADS * i, t = idx >> 4, c8 = (idx & 15) * 8;
        const f32x4 o0 = *(const LAS f32x4*)(Ot + t * LDO + c8), o1 = *(const LAS f32x4*)(Ot + t * LDO + c8 + 4); const float bt = sb[t];
        float fu[8], fg[8], o[8]; unpack8(uu[i], fu); unpack8(gt[i], fg);
        const float ov[8] = {o0.x, o0.y, o0.z, o0.w, o1.x, o1.y, o1.z, o1.w};
#pragma unroll
        for (int j = 0; j < 8; ++j) o[j] = fu[j] * (ov[j] + bt) * silu_f(fg[j]);
        *(u32x4*)(y + (size_t)t * DM + g * 128 + c8) = pack8f(o); }
    __syncthreads();
}

DI void conv_unit(CParams& P, int l, int u, LAS unsigned char* lds, int tid_, int lane_, int wave_) {
    int tid = tid_; asm volatile("" : "+v"(tid)); const int lane = tid & 63; const int wave = __builtin_amdgcn_readfirstlane(tid >> 6);
    const int cgp = u & 7, stl = (u >> 3) & 15, b = u >> 7; const int s0 = stl * 128;
    const bf16_t* proj = (const bf16_t*)(P.ws + WS_PROJ) + (size_t)(b * SEQ) * NPROJ;
    bf16_t* y = (bf16_t*)(P.ws + WS_Y) + (size_t)(b * SEQ) * DM;
    LAS float* glu = (LAS float*)lds;
    u32x4 ra[5], rb[5];
#pragma unroll
    for (int i = 0; i < 5; ++i) { int idx = tid + NTHREADS * i; idx = idx < 158 * 16 ? idx : 158 * 16 - 1; const int sl = idx >> 4, c8 = (idx & 15) * 8; int sg = s0 - 30 + sl; sg = sg > 0 ? sg : 0;
        const bf16_t* pr = proj + (size_t)sg * NPROJ + cgp * 128 + c8; ra[i] = *(const u32x4*)(pr + C_BA); rb[i] = *(const u32x4*)(pr + C_BB); }
#pragma unroll
    for (int i = 0; i < 5; ++i) { const int idx = tid + NTHREADS * i;
        if (idx < 158 * 16) { const int sl = idx >> 4, c8 = (idx & 15) * 8, sg = s0 - 30 + sl; float a[8], bb[8], o[8]; unpack8(ra[i], a); unpack8(rb[i], bb);
#pragma unroll
            for (int j = 0; j < 8; ++j) { o[j] = a[j] * sigm_f(bb[j]); if (sg < 0) o[j] = 0.f; }
            *(LAS f32x4*)(glu + sl * 128 + c8) = (f32x4){o[0], o[1], o[2], o[3]}; *(LAS f32x4*)(glu + sl * 128 + c8 + 4) = (f32x4){o[4], o[5], o[6], o[7]}; } }
    const float* cw = P.conv_w + (size_t)l * 31 * GW + cgp * 128 + 2 * lane;
    f32x2 w[31];
    { const float* cwj = cw;
#pragma unroll
      for (int j = 0; j < 31; ++j) { w[j] = *(const f32x2*)cwj; cwj += GW; asm volatile("" : "+v"(cwj)); } }
    const f32x2 bias = *(const f32x2*)(P.conv_b + l * GW + cgp * 128 + 2 * lane);
    const f32x2 gn = *(const f32x2*)(P.conv_ng + l * GW + cgp * 128 + 2 * lane), gb = *(const f32x2*)(P.conv_nb + l * GW + cgp * 128 + 2 * lane);
    __syncthreads();
#pragma unroll 1
    for (int bb = 0; bb < 2; ++bb) { const int t0 = wave * 16 + bb * 8;
        unsigned gt[8];
#pragma unroll
        for (int i = 0; i < 8; ++i) gt[i] = *(const unsigned*)(proj + (size_t)(s0 + t0 + i) * NPROJ + C_BG + cgp * 128 + 2 * lane);
        f32x2 x[38];
#pragma unroll
        for (int r = 0; r < 38; ++r) x[r] = *(const LAS f32x2*)(glu + (t0 + r) * 128 + 2 * lane);
        f32x2 acc[8];
#pragma unroll
        for (int i = 0; i < 8; ++i) { acc[i] = bias;
#pragma unroll
            for (int j = 0; j < 31; ++j) acc[i] += w[j] * x[i + j]; }
        float ps[8], pss[8];
#pragma unroll
        for (int i = 0; i < 8; ++i) { ps[i] = acc[i].x + acc[i].y; pss[i] = acc[i].x * acc[i].x + acc[i].y * acc[i].y; }
        const float S1 = reduce8(ps, lane), S2 = reduce8(pss, lane);
        const float mean_l = S1 * (1.f / 128.f), var_l = S2 * (1.f / 128.f) - mean_l * mean_l, rstd_l = rsqrtf(fmaxf(var_l, 0.f) + EPS);
#pragma unroll
        for (int i = 0; i < 8; ++i) { const float mean = bcast_lane(mean_l, 8 * i), rstd = bcast_lane(rstd_l, 8 * i);
            const float a0 = (acc[i].x - mean) * rstd * gn.x + gb.x, a1 = (acc[i].y - mean) * rstd * gn.y + gb.y;
            *(unsigned*)(y + (size_t)(s0 + t0 + i) * DM + 1024 + cgp * 128 + 2 * lane) = pk2(silu_f(a0) * silu_f(bflo(gt[i])), silu_f(a1) * silu_f(bfhi(gt[i]))); } }
    __syncthreads();
}

DI void mem_unit(CParams& P, int l, int u, LAS unsigned char* lds, int tid_, int lane_, int wave_) {
    int tid = tid_; asm volatile("" : "+v"(tid)); const int lane = tid & 63; const int wave = __builtin_amdgcn_readfirstlane(tid >> 6);
    const int tt = u & 7, hh = (u >> 3) & 3, b = u >> 5;
    const bf16_t* proj = (const bf16_t*)(P.ws + WS_PROJ) + (size_t)(b * SEQ + tt * 256) * NPROJ;
    bf16_t* y = (bf16_t*)(P.ws + WS_Y) + (size_t)(b * SEQ + tt * 256) * DM;
    const bf16_t* kv = (const bf16_t*)(P.ws + WS_KV) + (size_t)(b * MEMLEN) * NKV + hh * 256;
    constexpr int LD = 136;
    LAS bf16_t* Kc = (LAS bf16_t*)lds; LAS bf16_t* Qc = (LAS bf16_t*)(lds + 69632); LAS bf16_t* Vc = (LAS bf16_t*)lds;
    f32x16 S[8];
#pragma unroll
    for (int i = 0; i < 8; ++i) S[i] = zero16();
    u32x4 ka[8], qa[8];
#define MEM_LOAD_KQ(rr) do { _Pragma("unroll") for (int i = 0; i < 8; ++i) { const int idx = tid + NTHREADS * i, m = idx >> 4, c8 = (idx & 15) * 8; \
        ka[i] = *(const u32x4*)(kv + (size_t)m * NKV + (rr) * 128 + c8); qa[i] = *(const u32x4*)(proj + (size_t)m * NPROJ + C_MQ + hh * 256 + (rr) * 128 + c8); } } while (0)
    MEM_LOAD_KQ(0);
#pragma unroll
    for (int rr = 0; rr < 2; ++rr) {
#pragma unroll
        for (int i = 0; i < 8; ++i) { const int idx = tid + NTHREADS * i, m = idx >> 4, c8 = (idx & 15) * 8; *(LAS u32x4*)(Kc + m * LD + c8) = ka[i]; *(LAS u32x4*)(Qc + m * LD + c8) = qa[i]; }
        if (rr == 0) MEM_LOAD_KQ(1);
        __syncthreads();
#pragma unroll
        for (int ks = 0; ks < 8; ++ks) { const bf16x8 bq = frag_row(Qc, LD, 32 * wave, 16 * ks, lane);
#pragma unroll
            for (int mt = 0; mt < 8; ++mt) { const bf16x8 a = frag_row(Kc, LD, 32 * mt, 16 * ks, lane); S[mt] = MFMA32(a, bq, S[mt]); } }
        __syncthreads();
    }
#undef MEM_LOAD_KQ
    u32x4 va[8];
#define MEM_LOAD_V(rr) do { _Pragma("unroll") for (int i = 0; i < 8; ++i) { const int idx = tid + NTHREADS * i, m = idx >> 4, c8 = (idx & 15) * 8; \
        va[i] = *(const u32x4*)(kv + (size_t)m * NKV + 1024 + (rr) * 128 + c8); } } while (0)
    MEM_LOAD_V(0);
    float mx = -3.0e38f;
#pragma unroll
    for (int mt = 0; mt < 8; ++mt)
#pragma unroll
        for (int i = 0; i < 16; ++i) mx = fmaxf(mx, S[mt][i]);
    mx = fmaxf(mx, __shfl_xor(mx, 32));
    const float cs = 1.4426950408889634f * 0.0625f; float sum = 0.f;
#pragma unroll
    for (int mt = 0; mt < 8; ++mt)
#pragma unroll
        for (int i = 0; i < 16; ++i) { const float p = exp2f((S[mt][i] - mx) * cs); S[mt][i] = p; sum += p; }
    sum += __shfl_xor(sum, 32);
    const float inv = 1.f / sum;
    bf16x8 Pk[8][2];
#pragma unroll
    for (int mt = 0; mt < 8; ++mt) { Pk[mt][0] = pack_acc<0>(S[mt]); Pk[mt][1] = pack_acc<1>(S[mt]); }
    const int r = lane & 31, h = lane >> 5; const int t = 32 * wave + r;
#pragma unroll
    for (int rr = 0; rr < 2; ++rr) {
#pragma unroll
        for (int i = 0; i < 8; ++i) { const int idx = tid + NTHREADS * i, m = idx >> 4, c8 = (idx & 15) * 8; *(LAS u32x4*)(Vc + m * LD + c8) = va[i]; }
        if (rr == 0) MEM_LOAD_V(1);
        u32x2 gw[4][4];
#pragma unroll
        for (int dt = 0; dt < 2; ++dt)
#pragma unroll
            for (int g4 = 0; g4 < 4; ++g4) gw[dt][g4] = *(const u32x2*)(proj + (size_t)t * NPROJ + C_MG + hh * 256 + rr * 128 + 32 * dt + 8 * g4 + 4 * h);
        __syncthreads();
        f32x16 O[4];
#pragma unroll
        for (int dt = 0; dt < 4; ++dt) O[dt] = zero16();
#pragma unroll
        for (int mt = 0; mt < 8; ++mt) { int ln = lane; asm volatile("" : "+v"(ln));
#pragma unroll
            for (int sx = 0; sx < 2; ++sx)
#pragma unroll
                for (int dt = 0; dt < 4; ++dt) { const bf16x8 a = frag_tr_perm(Vc, LD, 32 * mt + 16 * sx, 32 * dt, ln); O[dt] = MFMA32(a, Pk[mt][sx], O[dt]); }
            asm volatile("" : "+v"(O[0]), "+v"(O[1]), "+v"(O[2]), "+v"(O[3])); }
#pragma unroll
        for (int dt = 2; dt < 4; ++dt)
#pragma unroll
            for (int g4 = 0; g4 < 4; ++g4) gw[dt][g4] = *(const u32x2*)(proj + (size_t)t * NPROJ + C_MG + hh * 256 + rr * 128 + 32 * dt + 8 * g4 + 4 * h);
#pragma unroll
        for (int dt = 0; dt < 4; ++dt)
#pragma unroll
            for (int g4 = 0; g4 < 4; ++g4) { const int d = hh * 256 + rr * 128 + 32 * dt + 8 * g4 + 4 * h; const u32x2 gq = gw[dt][g4];
                const float o0 = O[dt][4 * g4 + 0] * inv * silu_f(bflo(gq.x)), o1 = O[dt][4 * g4 + 1] * inv * silu_f(bfhi(gq.x)), o2 = O[dt][4 * g4 + 2] * inv * silu_f(bflo(gq.y)), o3 = O[dt][4 * g4 + 3] * inv * silu_f(bfhi(gq.y));
                u32x2 w; w.x = pk2(o0, o1); w.y = pk2(o2, o3); *(u32x2*)(y + (size_t)t * DM + 3072 + d) = w; }
        __syncthreads();
    }
#undef MEM_LOAD_V
}

DI void ret_unit(CParams& P, int l, int u, LAS unsigned char* lds, int tid_, int lane_, int wave_) {
    int tid0 = tid_; asm volatile("" : "+v"(tid0)); const int wave = __builtin_amdgcn_readfirstlane(tid0 >> 6);
#define RET_FRESH() int tid = tid0; asm volatile("" : "+v"(tid)); const int lane = tid & 63, r = lane & 31, h = lane >> 5; (void)r; (void)h; (void)tid
    const int hh = u & 3, b = u >> 2;
    constexpr int LD = 264, LDP = 72, LDR = 256, IMG = 33792;
    LAS bf16_t* Qs = (LAS bf16_t*)lds; LAS bf16_t* Ks = (LAS bf16_t*)(lds + IMG); LAS bf16_t* Vs = (LAS bf16_t*)(lds + 2 * IMG);
    LAS bf16_t* Ps = (LAS bf16_t*)(lds + 3 * IMG); LAS bf16_t* R = (LAS bf16_t*)(lds + 3 * IMG + 9216);
    const float g64 = exp2f(64.f * log2f(1.f - exp2f(-5.f - (float)hh)));
    const float* ng = P.ret_ng + l * GW + hh * 256; const float* nbp = P.ret_nb + l * GW + hh * 256;
    f32x16 St[8];
#pragma unroll
    for (int i = 0; i < 8; ++i) St[i] = zero16();
#define RET_DMA(img, nn) do { const char* pj_ = (const char*)((const bf16_t*)(P.ws + WS_PROJ) + (size_t)(b * SEQ + (nn) * 64) * NPROJ + hh * 256 + ((img) == 0 ? C_CQ : ((img) == 1 ? C_CK : C_CV))); \
        _Pragma("unroll 1") for (int j = wave; j < 33; j += 8) { const int q = 64 * j + lane, row = q / 33, ch = q - row * 33; \
            const char* src = pj_ + (size_t)row * (NPROJ * 2) + (ch < 32 ? ch : 31) * 16; \
            __builtin_amdgcn_global_load_lds((const unsigned*)src, (LAS unsigned*)(lds + (img) * IMG + j * 1024), 16, 0, 0); } } while (0)
#define RET_VMWAIT() asm volatile("s_waitcnt vmcnt(0)" ::: "memory")
    { RET_FRESH(); RET_DMA(0, 0); RET_DMA(1, 0); RET_DMA(2, 0); }
    RET_VMWAIT();
    __syncthreads();
    for (int n = 0; n < 32; ++n) {
        const int rowbase = b * SEQ + n * 64;
        const bf16_t* proj = (const bf16_t*)(P.ws + WS_PROJ) + (size_t)rowbase * NPROJ;
        bf16_t* y = (bf16_t*)(P.ws + WS_Y) + (size_t)rowbase * DM;
        f32x16 C[2]; C[0] = zero16(); C[1] = zero16();
        u32x2 gate[8];
        {
        RET_FRESH();
#pragma unroll
        for (int dt = 0; dt < 8; ++dt) {
            int ln = lane; asm volatile("" : "+v"(ln));
            { const bf16x8 bS = pack_acc<0>(St[dt]);
#pragma unroll
              for (int ti = 0; ti < 2; ++ti) { const bf16x8 a = frag_row_perm(Qs, LD, 32 * ti, 32 * dt, ln); C[ti] = MFMA32(a, bS, C[ti]); } }
            { const bf16x8 bS = pack_acc<1>(St[dt]);
#pragma unroll
              for (int ti = 0; ti < 2; ++ti) { const bf16x8 a = frag_row_perm(Qs, LD, 32 * ti, 32 * dt + 16, ln); C[ti] = MFMA32(a, bS, C[ti]); } }
            asm volatile("" : "+v"(C[0]), "+v"(C[1]));
        }
#pragma unroll
        for (int ti = 0; ti < 2; ++ti)
#pragma unroll
            for (int i = 0; i < 16; ++i) C[ti][i] *= g64;
        }
        RET_VMWAIT();
        __syncthreads();
        if (wave < 4) { RET_FRESH(); const int ti = wave >> 1, si = wave & 1;
          f32x16 acc = zero16();
          if (si <= ti) {
#pragma unroll
              for (int ks = 0; ks < 16; ++ks) { const bf16x8 a = frag_row(Qs, LD, 32 * ti, 16 * ks, lane), bb = frag_row(Ks, LD, 32 * si, 16 * ks, lane); acc = MFMA32(a, bb, acc); } }
#pragma unroll
          for (int i = 0; i < 16; ++i) { const int t = 32 * ti + crow(i, h), s = 32 * si + r; float v = acc[i]; if (s > t) v = 0.f; Ps[t * LDP + s] = (bf16_t)f2bf(v); } }
        __syncthreads();
        {
        RET_FRESH();
        if (n + 1 < 32) RET_DMA(0, n + 1);
        bf16x8 bv[4];
#pragma unroll
        for (int ks = 0; ks < 4; ++ks) { bv[ks] = frag_tr(Vs, LD, 16 * ks, 32 * wave, lane);
#pragma unroll
            for (int ti = 0; ti < 2; ++ti) { const bf16x8 a = frag_row(Ps, LDP, 32 * ti, 16 * ks, lane); C[ti] = MFMA32(a, bv[ks], C[ti]); } }
#pragma unroll
        for (int ti = 0; ti < 2; ++ti)
#pragma unroll
            for (int i = 0; i < 16; ++i) R[(32 * ti + crow(i, h)) * LDR + 32 * wave + r] = (bf16_t)f2bf(C[ti][i]);
        asm volatile("" ::: "memory");
#pragma unroll
        for (int i = 0; i < 8; ++i) gate[i] = *(const u32x2*)(proj + (size_t)(wave * 8 + i) * NPROJ + C_CG + hh * 256 + 4 * lane);
#pragma unroll
        for (int dt = 0; dt < 8; ++dt) {
            int ln = lane; asm volatile("" : "+v"(ln));
#pragma unroll
            for (int i = 0; i < 16; ++i) St[dt][i] *= g64;
#pragma unroll
            for (int ks = 0; ks < 4; ++ks) { const bf16x8 a = frag_tr(Ks, LD, 16 * ks, 32 * dt, ln); St[dt] = MFMA32(a, bv[ks], St[dt]); }
            asm volatile("" : "+v"(St[dt])); }
        }
        RET_VMWAIT();
        __syncthreads();
        { RET_FRESH(); if (n + 1 < 32) { RET_DMA(1, n + 1); RET_DMA(2, n + 1); } }
        {
        RET_FRESH();
        float ps[8], pss[8];
#pragma unroll
        for (int i = 0; i < 8; ++i) { const u32x2 w = *(const LAS u32x2*)(R + (wave * 8 + i) * LDR + 4 * lane); const float v0 = bflo(w.x), v1 = bfhi(w.x), v2 = bflo(w.y), v3 = bfhi(w.y);
            ps[i] = (v0 + v1) + (v2 + v3); pss[i] = (v0 * v0 + v1 * v1) + (v2 * v2 + v3 * v3); }
        const float S1 = reduce8(ps, lane), S2 = reduce8(pss, lane);
        const float mean_l = S1 * (1.f / 256.f), var_l = S2 * (1.f / 256.f) - mean_l * mean_l, rstd_l = rsqrtf(fmaxf(var_l, 0.f) + EPS);
        const f32x4 gn = *(const f32x4*)(ng + 4 * lane), gb = *(const f32x4*)(nbp + 4 * lane);
#pragma unroll
        for (int i = 0; i < 8; ++i) { const float mean = bcast_lane(mean_l, 8 * i), rstd = bcast_lane(rstd_l, 8 * i);
            const u32x2 w2 = *(const LAS u32x2*)(R + (wave * 8 + i) * LDR + 4 * lane); const float v0 = bflo(w2.x), v1 = bfhi(w2.x), v2 = bflo(w2.y), v3 = bfhi(w2.y);
            const float g0 = bflo(gate[i].x), g1 = bfhi(gate[i].x), g2 = bflo(gate[i].y), g3 = bfhi(gate[i].y);
            const float o0 = ((v0 - mean) * rstd * gn.x + gb.x) * silu_f(g0), o1 = ((v1 - mean) * rstd * gn.y + gb.y) * silu_f(g1);
            const float o2 = ((v2 - mean) * rstd * gn.z + gb.z) * silu_f(g2), o3 = ((v3 - mean) * rstd * gn.w + gb.w) * silu_f(g3);
            u32x2 w; w.x = pk2(o0, o1); w.y = pk2(o2, o3); *(u32x2*)(y + (size_t)(wave * 8 + i) * DM + 2048 + hh * 256 + 4 * lane) = w; }
        }
    }
    RET_VMWAIT();
    __syncthreads();
#undef RET_FRESH
#undef RET_DMA
#undef RET_VMWAIT
}


#define XB_TMO      128
#define XB_XCNT(j)  (256  + 64 * (j))
#define XB_XSUB(j)  (1280 + 64 * (j))
#define XB_XGEN(j)  (2304 + 64 * (j))
#define XB_TOP      3328
#define XB_TOPGEN   3392
#define XCD_BAR_WORDS 3456
#define XB_SPIN_CAP (1u << 18)
DI unsigned xb_ld(unsigned* p)              { return __hip_atomic_load(p, __ATOMIC_RELAXED, __HIP_MEMORY_SCOPE_AGENT); }
DI unsigned xb_add(unsigned* p, unsigned v) { return __hip_atomic_fetch_add(p, v, __ATOMIC_RELAXED, __HIP_MEMORY_SCOPE_AGENT); }
DI unsigned xb_xcc_id() { return (unsigned)__builtin_amdgcn_s_getreg((3 << 11) | 20) & 0xFu; }
#define XB_SPIN(cond, bar) do { unsigned _sp = 0; while (cond) { __builtin_amdgcn_s_sleep(1); \
    if ((++_sp & 255u) == 0u) { if (xb_ld(&(bar)[XB_TMO])) break; if (_sp > XB_SPIN_CAP) { atomicAdd(&(bar)[XB_TMO], 1u); break; } } } } while (0)
struct XcdBarrier { unsigned* bar; unsigned x; volatile LAS unsigned* st; };
DI XcdBarrier xcd_barrier_post(unsigned* bar, volatile LAS unsigned* st) {
    XcdBarrier b; b.bar = bar; b.x = xb_xcc_id(); b.st = st;
    if (threadIdx.x == 0) (void)xb_add(&bar[XB_XCNT(b.x)], 1u);
    return b;
}
DI void xcd_barrier_complete(unsigned* bar, unsigned x, unsigned& nloc, unsigned& nx) {
    const unsigned G = gridDim.x * gridDim.y * gridDim.z;
    unsigned sum, cnt, mine, sp = 0u;
    for (;;) {
        sum = 0u; cnt = 0u; mine = 0u;
#pragma unroll
        for (unsigned j = 0; j < 16; ++j) { const unsigned c = xb_ld(&bar[XB_XCNT(j)]); sum += c; cnt += (c > 0u) ? 1u : 0u; mine = (j == x) ? c : mine; }
        if (sum == G) break;
        __builtin_amdgcn_s_sleep(1);
        if ((++sp & 255u) == 0u) { if (xb_ld(&bar[XB_TMO])) break; if (sp > XB_SPIN_CAP) { atomicAdd(&bar[XB_TMO], 1u); break; } }
    }
    nloc = mine > 0u ? mine : 1u; nx = cnt > 0u ? cnt : 1u;
}
DI void xcd_barrier(const XcdBarrier& b) {
    asm volatile("s_waitcnt vmcnt(0)" ::: "memory");
    __syncthreads();
    if (threadIdx.x == 0) {
        unsigned* bar = b.bar; unsigned bx_ = b.x; asm volatile("" : "+s"(bx_), "+s"(bar));
        __builtin_amdgcn_s_waitcnt(0);
        unsigned nloc = b.st[0], nx = b.st[1];
        if (nloc == 0u) { xcd_barrier_complete(bar, bx_, nloc, nx); b.st[0] = nloc; b.st[1] = nx; }
        const unsigned old = xb_add(&bar[XB_XSUB(bx_)], 1u);
        const unsigned gen = old / nloc;
        if (old + 1u == (gen + 1u) * nloc) {
            __builtin_amdgcn_fence(__ATOMIC_RELEASE, "agent");
            asm volatile("s_waitcnt vmcnt(0)" ::: "memory");
            const unsigned og = xb_add(&bar[XB_TOP], 1u);
            const unsigned tg = og / nx;
            if (og + 1u == (tg + 1u) * nx) xb_add(&bar[XB_TOPGEN], 1u);
            else XB_SPIN(xb_ld(&bar[XB_TOPGEN]) == tg, bar);
            __builtin_amdgcn_fence(__ATOMIC_ACQUIRE, "agent");
            xb_add(&bar[XB_XGEN(bx_)], 1u);
            asm volatile("s_waitcnt vmcnt(0)" ::: "memory");
        } else {
            XB_SPIN(xb_ld(&bar[XB_XGEN(bx_)]) == gen, bar);
            __builtin_amdgcn_fence(__ATOMIC_ACQUIRE, "agent");
            asm volatile("s_waitcnt vmcnt(0)" ::: "memory");
        }
    }
    __syncthreads();
}

__global__ void __launch_bounds__(NTHREADS, 2) fwd_megakernel(Params P_) {
    CParams* const kp = (CParams*)__builtin_amdgcn_kernarg_segment_ptr();
#define P (*({ CParams* q_ = kp; asm volatile("" : "+s"(q_)); q_; }))
    extern __shared__ __attribute__((aligned(16))) unsigned char lds_raw[];
    cg::grid_group grid = cg::this_grid();
    LAS unsigned char* lds = (LAS unsigned char*)lds_raw;
    volatile LAS int* misc = (volatile LAS int*)(lds + LDS_MAIN);
#define tid ((int)threadIdx.x)
#define lane (tid & 63)
#define wave (__builtin_amdgcn_readfirstlane(tid >> 6))
    const int G = gridDim.x, bx = blockIdx.x; const int vcu = (G % 8 == 0) ? (bx % 8) * (G / 8) + bx / 8 : bx;
    unsigned char* ws = P.ws;
    if (tid < 16) misc[tid] = 0;
    __syncthreads();
    const XcdBarrier xbar = xcd_barrier_post((unsigned*)(ws + WS_CTL) + 4096, (volatile LAS unsigned*)(misc + 8));

#ifndef NO_PRO
    prologue(P, lds, vcu, G, tid, lane, wave);
#endif
    if (G == 0x7fffffff) grid.sync();
    xcd_barrier(xbar);

    _Pragma("unroll") for (int l = 0; l < DEPTH; ++l) {
        const float* rss_in = (const float*)(ws + (l == 0 ? WS_RSS0 : WS_RSS1));
        float* rss_out = (float*)(ws + (l == 0 ? WS_RSS1 : WS_RSS2));
        const pg8::Gemm g_in{(const bf16_t*)(ws + WS_XB), (const bf16_t*)(ws + WS_WIN) + (size_t)l * NPROJ * DM, MTOK, NPROJ, DM};
        const pg8::EpiProj E_in{(bf16_t*)(ws + WS_PROJ), NPROJ, rss_in, 1.f / DM, EPS, 1, (const float*)(ws + WS_COS), (const float*)(ws + WS_SIN), (float*)(ws + WS_AVSTAT) + (size_t)l * MTOK * 2};
        { const pg8::SubOrder S{16, 1024, 16, 24, 24, bx, G, 0};
          pg8::gemm_phase<pg8::EpiProj, pg8::SubOrder, true, true>(lds, g_in, S, E_in); }
        xcd_barrier(xbar);
#ifndef NO_RET
        if (bx < 32) ret_unit(P, l, bx, lds, tid, lane, wave);
#endif
        { const pg8::SubOrder S{32, 2048, 24, 0, 16, bx, G, 1};
          pg8::gemm_phase<pg8::EpiProj, pg8::SubOrder, true, true>(lds, g_in, S, E_in); }
        { pg8::Gemm g{(const bf16_t*)(ws + WS_MEMB), (const bf16_t*)(ws + WS_WKV) + (size_t)l * NKV * DM, MROWS, NKV, DM}; pg8::StaticOrder S; S.init(MROWS, NKV, G, (bx >= 96 && bx < 160) ? bx - 96 : (1 << 20));
          pg8::EpiProj E{(bf16_t*)(ws + WS_KV), NKV, nullptr, 0.f, 0.f, 0, nullptr, nullptr, nullptr};
          pg8::gemm_phase<pg8::EpiProj, pg8::StaticOrder, true, true>(lds, g, S, E); }
        if (bx >= 160) { int t2 = threadIdx.x; asm volatile("" : "+v"(t2)); const int w2 = __builtin_amdgcn_readfirstlane(t2 >> 6);
            convert_weights(P, 1, lds, (bx - 160) * NWAVES + w2, 96 * NWAVES, t2 & 63, w2, l == 0 ? 5 : 2); }
        xcd_barrier(xbar);
#pragma unroll 1
        for (int k = 0; k < 9; ++k) { int u = bx + 256 * (k == 0 ? 0 : (k - 1) & 3); asm volatile("" : "+s"(u));
            if (k == 0) mem_unit(P, l, u, lds, tid, lane, wave);
            else if (k < 5) sgu_unit(P, l, u, lds, tid, lane, wave);
            else conv_unit(P, l, u, lds, tid, lane, wave); }
        xcd_barrier(xbar);
        { pg8::Gemm g{(const bf16_t*)(ws + WS_Y), (const bf16_t*)(ws + WS_WOUT) + (size_t)l * DM * DM, MTOK, DM, DM}; pg8::StaticOrder S; S.init(MTOK, DM, G, bx);
          pg8::EpiRes E{l == 0 ? P.x : (const float*)nullptr, (bf16_t*)(ws + WS_XB), rss_out, DM};
          pg8::gemm_phase<pg8::EpiRes, pg8::StaticOrder, true, true>(lds, g, S, E); }
        xcd_barrier(xbar);
    }
#undef tid
#undef lane
#undef wave
    { int t2 = threadIdx.x; asm volatile("" : "+v"(t2)); const int lane = t2 & 63, wave = __builtin_amdgcn_readfirstlane(t2 >> 6);
      const int gw = vcu * NWAVES + wave, NGW = G * NWAVES; const float* rss = (const float*)(ws + WS_RSS2);
      const f32x4* gr = (const f32x4*)P.fin_g + 2 * lane; float* outp = P.out;
      for (int m = gw; m < MTOK; m += NGW) { const float rstd = rsqrtf(rss[m] * (1.f / DM) + EPS);
          const u32x4* xr = (const u32x4*)((const bf16_t*)(ws + WS_XB) + (size_t)m * DM) + lane; f32x4* orow = (f32x4*)(outp + (size_t)m * DM) + 2 * lane;
          u32x4 xv[8];
#pragma unroll
          for (int j = 0; j < 8; ++j) xv[j] = xr[64 * j];
#pragma unroll
          for (int j = 0; j < 8; ++j) { float f[8]; unpack8(xv[j], f); const f32x4 g0 = gr[128 * j], g1 = gr[128 * j + 1];
              orow[128 * j] = (f32x4){f[0], f[1], f[2], f[3]} * rstd * g0; orow[128 * j + 1] = (f32x4){f[4], f[5], f[6], f[7]} * rstd * g1; } } }
}

#undef P
extern "C" void kernel_launch(void* const* d_in, const int* in_sizes, int n_in, void* d_out, int out_size, void* d_ws, size_t ws_size, hipStream_t stream) {
    static int grid = 0;
    if (grid == 0) {
        if (n_in != 19 || in_sizes[0] != MTOK * DM || out_size != MTOK * DM || ws_size < WS_END) { fprintf(stderr, "kernel_launch: unexpected shapes (n_in %d, in0 %d, out %d, ws %zu < %zu)\n", n_in, n_in > 0 ? in_sizes[0] : -1, out_size, ws_size, (size_t)WS_END); grid = -1; return; }
        int dev = 0, cus = 0, per_cu = 0;
        if (hipGetDevice(&dev) != hipSuccess || hipDeviceGetAttribute(&cus, hipDeviceAttributeMultiprocessorCount, dev) != hipSuccess) { grid = -1; return; }
        if (hipFuncSetAttribute((const void*)fwd_megakernel, hipFuncAttributeMaxDynamicSharedMemorySize, LDS_BYTES) != hipSuccess) { fprintf(stderr, "kernel_launch: hipFuncSetAttribute failed\n"); grid = -1; return; }
        if (hipOccupancyMaxActiveBlocksPerMultiprocessor(&per_cu, (const void*)fwd_megakernel, NTHREADS, LDS_BYTES) != hipSuccess || per_cu < 1) { fprintf(stderr, "kernel_launch: occupancy query says %d\n", per_cu); per_cu = 1; }
        (void)hipGetLastError();
        grid = cus * per_cu;
        if (grid != 256) { fprintf(stderr, "kernel_launch: this kernel's phase program is laid out for a 256-workgroup grid (256 CUs x 1); got %d x %d\n", cus, per_cu); grid = -1; return; }
    }
    if (grid < 0) return;
    if (hipMemsetAsync((char*)d_ws + WS_CTL, 0, CTL_ZERO_BYTES, stream) != hipSuccess) { fprintf(stderr, "kernel_launch: memset failed\n"); return; }
    Params p{};
    p.x = (const float*)d_in[0]; p.mem = (const float*)d_in[1]; p.pos = (const int*)d_in[2]; p.norm_g = (const float*)d_in[3]; p.w_in = (const float*)d_in[4];
    p.sgu_ng = (const float*)d_in[5]; p.sgu_nb = (const float*)d_in[6]; p.sgu_w = (const float*)d_in[7]; p.sgu_b = (const float*)d_in[8];
    p.conv_w = (const float*)d_in[9]; p.conv_b = (const float*)d_in[10]; p.conv_ng = (const float*)d_in[11]; p.conv_nb = (const float*)d_in[12];
    p.ret_ng = (const float*)d_in[13]; p.ret_nb = (const float*)d_in[14]; p.mem_ng = (const float*)d_in[15]; p.w_kv = (const float*)d_in[16]; p.w_out = (const float*)d_in[17]; p.fin_g = (const float*)d_in[18];
    p.out = (float*)d_out; p.ws = (unsigned char*)d_ws;
    void* args[] = {&p};
    hipError_t e = hipLaunchCooperativeKernel((const void*)fwd_megakernel, dim3(grid), dim3(NTHREADS), args, LDS_BYTES, stream);
    if (e != hipSuccess) fprintf(stderr, "kernel_launch: cooperative launch failed: %s (grid %d)\n", hipGetErrorString(e), grid);
}
```

```cpp
#include <hip/hip_runtime.h>
#include <hip/hip_cooperative_groups.h>
#include <cstdio>
#include <cstdint>
namespace cg = cooperative_groups;

#define DI __device__ __forceinline__
#define LAS __attribute__((address_space(3)))
typedef unsigned short bf16_t;
typedef short bf16x8 __attribute__((ext_vector_type(8)));
typedef short s16x4 __attribute__((ext_vector_type(4)));
typedef float f32x4 __attribute__((ext_vector_type(4)));
typedef float f32x2 __attribute__((ext_vector_type(2)));
typedef float f32x16 __attribute__((ext_vector_type(16)));
typedef unsigned u32x4 __attribute__((ext_vector_type(4)));
typedef unsigned u32x2 __attribute__((ext_vector_type(2)));

namespace pg8 {
constexpr int BM = 256, BK = 64, HALF = 128, HTB = HALF * BK * 2, STAGE_BYTES = 8 * HTB, NXCD = 8, WGM = 8;
__host__ __device__ __forceinline__ int lds_byte(int r, int c) { const int st = (r >> 4) * 2 + (c >> 5), rr = r & 15, cc = c & 31, ob = rr * 64 + cc * 2; return st * 1024 + (ob ^ (((ob >> 9) & 1) << 5)); }
__host__ __device__ __forceinline__ void stage_rc(int b, int& R, int& C) { const int st = b / 1024, sb = b % 1024, swz = sb ^ (((sb >> 9) & 1) << 5); R = (st >> 1) * 16 + swz / 64; C = (st & 1) * 32 + (swz % 64) / 2; }
__host__ __device__ __forceinline__ int perm32(int rho) { const int n = rho >> 4, i = rho & 15; return 8 * (i >> 2) + 4 * n + (i & 3); }
struct Unit { int pm, pn; };
struct Gemm { const bf16_t* A; const bf16_t* Bt; int M, N, K; };
struct StaticOrder {
    int nM, nN, nwg, G, c;
    __host__ __device__ void init(int M, int N, int G_, int c_) { nM = M / BM; nN = N / BM; nwg = nM * nN; G = G_; c = c_; }
    __host__ __device__ bool next(int i, Unit& u) const {
        const long L = (long)i * G + c; if (L >= nwg) return false;
        int wgid = (int)L; { const int q = nwg / NXCD, r = nwg % NXCD, xcd = wgid % NXCD, off = wgid / NXCD; wgid = (xcd < r ? xcd * (q + 1) : r * (q + 1) + (xcd - r) * q) + off; }
        const int nig = WGM * nN, gid = wgid / nig, fm = gid * WGM, gsz = (nM - fm) < WGM ? (nM - fm) : WGM;
        u.pm = fm + ((wgid % nig) % gsz); u.pn = (wgid % nig) / gsz; return true;
    }
    __device__ __forceinline__ void a_ready(const Unit&) const {}
    __device__ __forceinline__ void done(const Unit&) const {}
};
struct SubOrder {
    int nNv, nwg, split, off0, off1, c, G, mode;
    __device__ __forceinline__ bool next(int i, Unit& u) const {
        int L;
        if (mode == 0) { L = i * G + c; if (L >= nwg) return false; }
        else if (c >= 32) { if (i < 8) L = i * 224 + (c - 32); else if (i == 8 && c < 96) L = 1984 + (c - 32); else return false; }
        else { if (i < 6) L = 1792 + i * 32 + c; else return false; }
        int wgid = L; { const int q = nwg / NXCD, xcd = wgid % NXCD, off = wgid / NXCD; wgid = xcd * q + off; }
        const int nig = WGM * nNv, gid = wgid / nig; const int pv = (wgid % nig) / WGM;
        u.pm = gid * WGM + ((wgid % nig) % WGM); u.pn = pv < split ? pv + off0 : pv + off1; return true;
    }
    __device__ __forceinline__ void a_ready(const Unit&) const {}
    __device__ __forceinline__ void done(const Unit&) const {}
};
__device__ __forceinline__ unsigned cvt_pk_bf16(float lo, float hi) { unsigned r; asm volatile("v_cvt_pk_bf16_f32 %0, %1, %2" : "=v"(r) : "v"(lo), "v"(hi)); return r; }

struct EpiProj {
    static constexpr bool PERM = true, AFTER_DRAIN = false;
    bf16_t* O; int ldc; const float* rss; float invk, eps; int mode; const float* ctab; const float* stab; float* avstat;
    __device__ __forceinline__ void operator()(const f32x4 (&acc)[2][2][4][2], const Unit& u, int wr, int wc, int fr, int fq) const {
        const int row0 = u.pm * BM + wr * 64 + fr; const int col0 = u.pn * BM + wc * 32 + 8 * fq;
        const bool rot = mode == 1 && u.pn >= 24 && u.pn < 32, stat = mode == 1 && u.pn >= 4 && u.pn < 8;
        float lg2 = 0.f, kmul = 1.f;
        if (rot) { const int hd = (u.pn - 24) & 3; lg2 = log2f(1.f - exp2f(-5.f - (float)hd)); if (u.pn >= 28) { lg2 = -lg2; kmul = 0.0625f; } }
#pragma unroll
        for (int ai = 0; ai < 2; ++ai)
#pragma unroll
            for (int m = 0; m < 4; ++m) { const int row = row0 + ai * HALF + m * 16; bf16_t* rowp = O + (size_t)row * ldc + col0;
                float sc = 1.f; if (rss) sc = rsqrtf(rss[row] * invk + eps);
                f32x4 v[2][2];
#pragma unroll
                for (int bj = 0; bj < 2; ++bj)
#pragma unroll
                    for (int n = 0; n < 2; ++n) v[bj][n] = acc[ai][bj][m][n] * sc;
                if (rot) { const float f = exp2f((float)(row & 63) * lg2) * kmul; const int j0 = wc * 32 + 8 * fq;
#pragma unroll
                    for (int n = 0; n < 2; ++n) { const f32x4 cs = *(const f32x4*)(ctab + (size_t)row * 128 + j0 + 4 * n), sn = *(const f32x4*)(stab + (size_t)row * 128 + j0 + 4 * n);
                        const f32x4 x1 = v[0][n], x2 = v[1][n]; v[0][n] = (x1 * cs - x2 * sn) * f; v[1][n] = (x2 * cs + x1 * sn) * f; } }
                if (stat) { float s1 = 0.f, s2 = 0.f;
#pragma unroll
                    for (int bj = 0; bj < 2; ++bj)
#pragma unroll
                        for (int n = 0; n < 2; ++n) { const f32x4 x = v[bj][n]; s1 += (x[0] + x[1]) + (x[2] + x[3]); s2 += (x[0] * x[0] + x[1] * x[1]) + (x[2] * x[2] + x[3] * x[3]); }
                    s1 += __shfl_xor(s1, 16); s1 += __shfl_xor(s1, 32); s2 += __shfl_xor(s2, 16); s2 += __shfl_xor(s2, 32);
                    if (fq == 0) { atomicAdd(avstat + 2 * row, s1); atomicAdd(avstat + 2 * row + 1, s2); } }
#pragma unroll
                for (int bj = 0; bj < 2; ++bj) { const f32x4 v0 = v[bj][0], v1 = v[bj][1];
                    u32x4 w; w.x = cvt_pk_bf16(v0[0], v0[1]); w.y = cvt_pk_bf16(v0[2], v0[3]); w.z = cvt_pk_bf16(v1[0], v1[1]); w.w = cvt_pk_bf16(v1[2], v1[3]);
                    *(u32x4*)(rowp + bj * HALF) = w; } }
    }
};
struct EpiRes {
    static constexpr bool PERM = true, AFTER_DRAIN = false;
    const float* basef; bf16_t* xb; float* rss; int ldc;
    __device__ __forceinline__ void operator()(const f32x4 (&acc)[2][2][4][2], const Unit& u, int wr, int wc, int fr, int fq) const {
        const int col0 = u.pn * BM + wc * 32 + 8 * fq;
#pragma unroll
        for (int ai = 0; ai < 2; ++ai)
#pragma unroll
            for (int m = 0; m < 4; ++m) { const int r = u.pm * BM + ai * HALF + wr * 64 + m * 16 + fr; const size_t off = (size_t)r * ldc + col0; float ss = 0.f;
#pragma unroll
                for (int bj = 0; bj < 2; ++bj) { f32x4 b0, b1;
                    if (basef) { b0 = *(const f32x4*)(basef + off + bj * HALF); b1 = *(const f32x4*)(basef + off + bj * HALF + 4); }
                    else { const u32x4 wb = *(const u32x4*)(xb + off + bj * HALF);
                        b0 = (f32x4){__uint_as_float(wb.x << 16), __uint_as_float(wb.x & 0xffff0000u), __uint_as_float(wb.y << 16), __uint_as_float(wb.y & 0xffff0000u)};
                        b1 = (f32x4){__uint_as_float(wb.z << 16), __uint_as_float(wb.z & 0xffff0000u), __uint_as_float(wb.w << 16), __uint_as_float(wb.w & 0xffff0000u)}; }
                    const f32x4 o0 = b0 + acc[ai][bj][m][0], o1 = b1 + acc[ai][bj][m][1];
                    ss += ((o0[0] * o0[0] + o0[1] * o0[1]) + (o0[2] * o0[2] + o0[3] * o0[3])) + ((o1[0] * o1[0] + o1[1] * o1[1]) + (o1[2] * o1[2] + o1[3] * o1[3]));
                    u32x4 w; w.x = cvt_pk_bf16(o0[0], o0[1]); w.y = cvt_pk_bf16(o0[2], o0[3]); w.z = cvt_pk_bf16(o1[0], o1[1]); w.w = cvt_pk_bf16(o1[2], o1[3]);
                    *(u32x4*)(xb + off + bj * HALF) = w; }
                ss += __shfl_xor(ss, 16); ss += __shfl_xor(ss, 32);
                if (fq == 0) atomicAdd(rss + r, ss); }
    }
};

template <class Epi, class Sched, bool ALIGN_EPI = false, bool SP2 = false>
__device__ __forceinline__ void gemm_phase(LAS unsigned char* lds, const Gemm g, const Sched& S, const Epi& E) {
    int tid = threadIdx.x; asm volatile("" : "+v"(tid));
    const int wid = __builtin_amdgcn_readfirstlane(tid >> 6), lane = tid & 63, wr = wid >> 2, wc = wid & 3, fr = lane & 15, fq = lane >> 4;
    const int K = g.K, nt = K / BK;
    unsigned voffA[2], voffB[2];
#pragma unroll
    for (int i = 0; i < 2; ++i) { int R, C; stage_rc(tid * 16 + i * 8192, R, C); const int Rb = Epi::PERM ? ((R & ~31) + perm32(R & 31)) : R;
        voffA[i] = (unsigned)(R * K + C) * 2u; voffB[i] = (unsigned)(Rb * K + C) * 2u; }
    const size_t kstep = (size_t)(BK * 2);
    const size_t hstep = (size_t)HALF * K * 2;
    const size_t tstep = 2 * hstep;
    const unsigned ldsw = (unsigned)wid * 1024u;
    const int aoff = lds_byte(wr * 64 + fr, fq * 8), boff = lds_byte(wc * 32 + fr, fq * 8);
#define PG8_SA(b, h) (((b) * 2 + (h)) * HTB)
#define PG8_SB(b, h) ((4 + (b) * 2 + (h)) * HTB)
#define PG8_STAGE(bufoff, gbase, voff) do { _Pragma("unroll") for (int _i = 0; _i < 2; ++_i) \
        __builtin_amdgcn_global_load_lds((const unsigned*)((const char*)(gbase) + (voff)[_i]), (LAS unsigned*)(lds + (bufoff) + ldsw + _i * 8192), 16, 0, 0); } while (0)
#define PG8_LDA(dst, b, h) do { _Pragma("unroll") for (int m = 0; m < 4; ++m) _Pragma("unroll") for (int k = 0; k < 2; ++k) dst[m][k] = *(const LAS bf16x8*)(lds + PG8_SA(b, h) + aoff + m * 2048 + k * 1024); } while (0)
#define PG8_LDB(dst, b, h) do { _Pragma("unroll") for (int n = 0; n < 2; ++n) _Pragma("unroll") for (int k = 0; k < 2; ++k) dst[n][k] = *(const LAS bf16x8*)(lds + PG8_SB(b, h) + boff + n * 2048 + k * 1024); } while (0)
#define PG8_MMA(ai, bj, At, Bt) do { __builtin_amdgcn_s_setprio(1); _Pragma("unroll") for (int m = 0; m < 4; ++m) _Pragma("unroll") for (int n = 0; n < 2; ++n) _Pragma("unroll") for (int k = 0; k < 2; ++k) \
        acc[ai][bj][m][n] = __builtin_amdgcn_mfma_f32_16x16x32_bf16(Bt[n][k], At[m][k], acc[ai][bj][m][n], 0, 0, 0); __builtin_amdgcn_s_setprio(0); } while (0)
#define PG8_WAIT_V(n) asm volatile("s_waitcnt vmcnt(" #n ")" ::: "memory")
#define PG8_WAIT_L(n) asm volatile("s_waitcnt lgkmcnt(" #n ")" ::: "memory")
#define PG8_BAR __builtin_amdgcn_s_barrier()
#define PG8_SCHED __builtin_amdgcn_sched_barrier(0)
    Unit cur, nxt; int ui = 0;
    if (!S.next(0, cur)) return;
    f32x4 acc[2][2][4][2];
#pragma unroll
    for (int a = 0; a < 2; ++a)
#pragma unroll
        for (int b = 0; b < 2; ++b)
#pragma unroll
            for (int m = 0; m < 4; ++m)
#pragma unroll
                for (int n = 0; n < 2; ++n) acc[a][b][m][n] = (f32x4){0.f, 0.f, 0.f, 0.f};
    bf16x8 At[4][2], B0[2][2], B1[2][2];
    const char* cA = (const char*)g.A + (size_t)cur.pm * tstep; const char* cB = (const char*)g.Bt + (size_t)cur.pn * tstep;
    S.a_ready(cur);
    if constexpr (SP2) {
        PG8_STAGE(PG8_SB(0, 0), cB, voffB); PG8_STAGE(PG8_SB(0, 1), cB + hstep, voffB); PG8_STAGE(PG8_SA(0, 0), cA, voffA); PG8_STAGE(PG8_SA(0, 1), cA + hstep, voffA);
        if (wr == 1) PG8_BAR;
        PG8_WAIT_V(2); PG8_BAR;
        PG8_STAGE(PG8_SB(1, 0), cB + kstep, voffB); PG8_STAGE(PG8_SA(1, 0), cA + kstep, voffA); PG8_STAGE(PG8_SB(1, 1), cB + hstep + kstep, voffB);
        PG8_WAIT_V(6); PG8_BAR;
    } else {
        PG8_STAGE(PG8_SB(0, 0), cB, voffB); PG8_STAGE(PG8_SA(0, 0), cA, voffA); PG8_STAGE(PG8_SB(0, 1), cB + hstep, voffB); PG8_STAGE(PG8_SA(0, 1), cA + hstep, voffA);
        if (wr == 1) PG8_BAR;
        PG8_WAIT_V(4); PG8_BAR;
        PG8_STAGE(PG8_SB(1, 0), cB + kstep, voffB); PG8_STAGE(PG8_SA(1, 0), cA + kstep, voffA); PG8_STAGE(PG8_SB(1, 1), cB + hstep + kstep, voffB);
        PG8_WAIT_V(6); PG8_BAR;
    }
    for (;;) {
        const bool has_next = S.next(ui + 1, nxt);
        const char* nA = has_next ? (const char*)g.A + (size_t)nxt.pm * tstep : cA; const char* nB = has_next ? (const char*)g.Bt + (size_t)nxt.pn * tstep : cB;
        for (int t = 0; t < nt; t += 2) {
            const bool last = (t == nt - 2);
            const char* a1 = cA + (size_t)(t + 1) * kstep;
            const char* a2 = last ? nA : cA + (size_t)(t + 2) * kstep; const char* b2 = last ? nB : cB + (size_t)(t + 2) * kstep;
            const char* a3 = a2 + kstep; const char* b3 = b2 + kstep;
            if (last && has_next) S.a_ready(nxt);
            if constexpr (SP2) {
            PG8_LDB(B0, 0, 0); PG8_LDB(B1, 0, 1); PG8_SCHED; PG8_LDA(At, 0, 0); PG8_STAGE(PG8_SA(1, 1), a1 + hstep, voffA);
            PG8_WAIT_V(8); PG8_WAIT_L(0); PG8_BAR; PG8_MMA(0, 0, At, B0); PG8_MMA(0, 1, At, B1); PG8_BAR; PG8_SCHED;
            PG8_LDA(At, 0, 1); PG8_STAGE(PG8_SB(0, 0), b2, voffB); PG8_STAGE(PG8_SB(0, 1), b2 + hstep, voffB); PG8_STAGE(PG8_SA(0, 0), a2, voffA);
            PG8_WAIT_V(8); PG8_WAIT_L(0); PG8_BAR; PG8_MMA(1, 0, At, B0); PG8_MMA(1, 1, At, B1); PG8_BAR; PG8_SCHED;
            PG8_LDB(B0, 1, 0); PG8_LDB(B1, 1, 1); PG8_SCHED; PG8_LDA(At, 1, 0); PG8_STAGE(PG8_SA(0, 1), a2 + hstep, voffA);
            PG8_WAIT_V(8); PG8_WAIT_L(0); PG8_BAR; PG8_MMA(0, 0, At, B0); PG8_MMA(0, 1, At, B1); PG8_BAR; PG8_SCHED;
            PG8_LDA(At, 1, 1); PG8_STAGE(PG8_SB(1, 0), b3, voffB); PG8_STAGE(PG8_SB(1, 1), b3 + hstep, voffB); PG8_STAGE(PG8_SA(1, 0), a3, voffA);
            PG8_WAIT_V(8); PG8_WAIT_L(0); PG8_BAR; PG8_MMA(1, 0, At, B0); PG8_MMA(1, 1, At, B1); PG8_BAR; PG8_SCHED;
            } else {
            PG8_LDB(B0, 0, 0); PG8_SCHED; PG8_LDA(At, 0, 0); PG8_STAGE(PG8_SA(1, 1), a1 + hstep, voffA);
            PG8_WAIT_L(8); PG8_BAR; PG8_WAIT_L(0); PG8_MMA(0, 0, At, B0); PG8_BAR; PG8_SCHED;
            PG8_LDB(B1, 0, 1); PG8_STAGE(PG8_SB(0, 0), b2, voffB);
            PG8_BAR; PG8_WAIT_L(0); PG8_MMA(0, 1, At, B1); PG8_BAR;
            PG8_LDA(At, 0, 1); PG8_STAGE(PG8_SA(0, 0), a2, voffA);
            PG8_BAR; PG8_WAIT_L(0); PG8_MMA(1, 0, At, B0); PG8_BAR; PG8_SCHED;
            PG8_STAGE(PG8_SB(0, 1), b2 + hstep, voffB);
            PG8_WAIT_V(6); PG8_BAR; PG8_MMA(1, 1, At, B1); PG8_BAR;
            PG8_LDB(B0, 1, 0); PG8_SCHED; PG8_LDA(At, 1, 0); PG8_STAGE(PG8_SA(0, 1), a2 + hstep, voffA);
            PG8_WAIT_L(8); PG8_BAR; PG8_WAIT_L(0); PG8_MMA(0, 0, At, B0); PG8_BAR; PG8_SCHED;
            PG8_LDB(B1, 1, 1); PG8_STAGE(PG8_SB(1, 0), b3, voffB);
            PG8_BAR; PG8_WAIT_L(0); PG8_MMA(0, 1, At, B1); PG8_BAR;
            PG8_LDA(At, 1, 1); PG8_STAGE(PG8_SA(1, 0), a3, voffA);
            PG8_BAR; PG8_WAIT_L(0); PG8_MMA(1, 0, At, B0); PG8_BAR; PG8_SCHED;
            PG8_STAGE(PG8_SB(1, 1), b3 + hstep, voffB);
            PG8_WAIT_V(6); PG8_BAR; PG8_MMA(1, 1, At, B1); PG8_BAR;
            }
        }
        if constexpr (ALIGN_EPI) { if (wr == 0) PG8_BAR; }
        E(acc, cur, wr, wc, fr, fq); S.done(cur);
        if (!has_next) break;
#pragma unroll
        for (int a = 0; a < 2; ++a)
#pragma unroll
            for (int b = 0; b < 2; ++b)
#pragma unroll
                for (int m = 0; m < 4; ++m)
#pragma unroll
                    for (int n = 0; n < 2; ++n) acc[a][b][m][n] = (f32x4){0.f, 0.f, 0.f, 0.f};
        cur = nxt; cA = nA; cB = nB; ++ui;
        if constexpr (ALIGN_EPI) { if (wr == 1) PG8_BAR; }
    }
    PG8_WAIT_V(0);
    if constexpr (!ALIGN_EPI) { if (wr == 0) PG8_BAR; }
    PG8_BAR;
#undef PG8_SA
#undef PG8_SB
#undef PG8_STAGE
#undef PG8_LDA
#undef PG8_LDB
#undef PG8_MMA
#undef PG8_WAIT_V
#undef PG8_WAIT_L
#undef PG8_BAR
#undef PG8_SCHED
}
}

constexpr int DM = 4096, NB = 8, SEQ = 2048, MTOK = NB * SEQ, NPROJ = 12288, GW = 1024, MEMLEN = 256, MROWS = NB * MEMLEN, NKV = 2048, DEPTH = 2;
constexpr float EPS = 1e-6f;
constexpr int NWAVES = 8, NTHREADS = 512;
constexpr int C_AU = 0, C_AV = 1024, C_AG = 2048, C_BA = 3072, C_BB = 4096, C_BG = 5120, C_CQ = 6144, C_CK = 7168, C_CV = 8192, C_CG = 9216, C_MQ = 10240, C_MG = 11264;

constexpr size_t MiB = 1u << 20;
constexpr size_t WS_CTL = 0, CTL_ZERO_BYTES = 1 * MiB;
constexpr size_t WS_RSS1 = 64 * 1024, WS_RSS2 = 128 * 1024, WS_AVSTAT = 256 * 1024;
constexpr size_t WS_RSS0 = 1 * MiB;
constexpr size_t WS_WIN = 2 * MiB;
constexpr size_t WS_WOUT = WS_WIN + 192 * MiB;
constexpr size_t WS_WKV = WS_WOUT + 64 * MiB;
constexpr size_t WS_XB = WS_WKV + 32 * MiB;
constexpr size_t WS_PROJ = WS_XB + 128 * MiB;
constexpr size_t WS_Y = WS_PROJ + 384 * MiB;
constexpr size_t WS_MEMB = WS_Y + 128 * MiB;
constexpr size_t WS_KV = WS_MEMB + 16 * MiB;
constexpr size_t WS_COS = WS_KV + 8 * MiB;
constexpr size_t WS_SIN = WS_COS + 8 * MiB;
constexpr size_t WS_X1 = WS_SIN + 8 * MiB;
constexpr size_t WS_END = WS_X1 + 256 * MiB;

constexpr int LDS_MAIN = 163840 - 256, LDS_BYTES = 163840;

DI float bf2f(bf16_t v) { return __uint_as_float((unsigned)v << 16); }
DI float bflo(unsigned w) { return __uint_as_float(w << 16); }
DI float bfhi(unsigned w) { return __uint_as_float(w & 0xffff0000u); }
DI unsigned f2bf(float f) { unsigned u = __float_as_uint(f); return (u + 0x7fffu + ((u >> 16) & 1u)) >> 16; }
typedef __bf16 bf16v2 __attribute__((ext_vector_type(2)));
DI unsigned pk2(float lo, float hi) { f32x2 v = {lo, hi}; bf16v2 b = __builtin_convertvector(v, bf16v2); return __builtin_bit_cast(unsigned, b); }
DI float silu_f(float x) { return x * __builtin_amdgcn_rcpf(1.f + __expf(-x)); }
DI float sigm_f(float x) { return __builtin_amdgcn_rcpf(1.f + __expf(-x)); }
DI float wave_sum(float v) {
#pragma unroll
    for (int o = 1; o < 64; o <<= 1) v += __shfl_xor(v, o);
    return v;
}
DI void unpack8(const u32x4 w, float (&f)[8]) { f[0] = bflo(w.x); f[1] = bfhi(w.x); f[2] = bflo(w.y); f[3] = bfhi(w.y); f[4] = bflo(w.z); f[5] = bfhi(w.z); f[6] = bflo(w.w); f[7] = bfhi(w.w); }
DI u32x4 pack8f(const float (&f)[8]) { u32x4 w; w.x = pk2(f[0], f[1]); w.y = pk2(f[2], f[3]); w.z = pk2(f[4], f[5]); w.w = pk2(f[6], f[7]); return w; }
DI int crow(int reg, int h) { return (reg & 3) + 8 * (reg >> 2) + 4 * h; }
#define MFMA32(a, b, c) __builtin_amdgcn_mfma_f32_32x32x16_bf16((a), (b), (c), 0, 0, 0)

DI bf16x8 frag_row(const LAS bf16_t* img, int ld, int row0, int k0, int lane) { return *(const LAS bf16x8*)(img + (row0 + (lane & 31)) * ld + k0 + 8 * (lane >> 5)); }
DI bf16x8 frag_row_perm(const LAS bf16_t* img, int ld, int row0, int k0, int lane) {
    const LAS bf16_t* p = img + (row0 + (lane & 31)) * ld + k0 + 4 * (lane >> 5);
    const s16x4 lo = *(const LAS s16x4*)p, hi = *(const LAS s16x4*)(p + 8);
    return __builtin_shufflevector(lo, hi, 0, 1, 2, 3, 4, 5, 6, 7);
}
DI s16x4 tr16(const LAS bf16_t* p) { return __builtin_amdgcn_ds_read_tr16_b64_v4i16((LAS s16x4*)p); }
DI bf16x8 frag_tr(const LAS bf16_t* img, int ld, int k0, int x0, int lane) {
    const int h = lane >> 5, blk = (lane >> 4) & 1, q = (lane & 15) >> 2, p = lane & 3;
    const LAS bf16_t* a = img + (k0 + 8 * h + q) * ld + x0 + 16 * blk + 4 * p;
    const s16x4 lo = tr16(a), hi = tr16(a + 4 * ld);
    return __builtin_shufflevector(lo, hi, 0, 1, 2, 3, 4, 5, 6, 7);
}
DI bf16x8 frag_tr_perm(const LAS bf16_t* img, int ld, int k0, int x0, int lane) {
    const int h = lane >> 5, blk = (lane >> 4) & 1, q = (lane & 15) >> 2, p = lane & 3;
    const LAS bf16_t* a = img + (k0 + 4 * h + q) * ld + x0 + 16 * blk + 4 * p;
    const s16x4 lo = tr16(a), hi = tr16(a + 8 * ld);
    return __builtin_shufflevector(lo, hi, 0, 1, 2, 3, 4, 5, 6, 7);
}
template <int S> DI bf16x8 pack_acc(const f32x16& x) {
    u32x4 p; p.x = pk2(x[8 * S + 0], x[8 * S + 1]); p.y = pk2(x[8 * S + 2], x[8 * S + 3]); p.z = pk2(x[8 * S + 4], x[8 * S + 5]); p.w = pk2(x[8 * S + 6], x[8 * S + 7]);
    return __builtin_bit_cast(bf16x8, p);
}
DI f32x16 zero16() { f32x16 z;
#pragma unroll
    for (int i = 0; i < 16; ++i) z[i] = 0.f; return z; }

struct Params {
    const float* x; const float* mem; const int* pos; const float* norm_g; const float* w_in; const float* sgu_ng; const float* sgu_nb; const float* sgu_w; const float* sgu_b;
    const float* conv_w; const float* conv_b; const float* conv_ng; const float* conv_nb; const float* ret_ng; const float* ret_nb; const float* mem_ng; const float* w_kv; const float* w_out; const float* fin_g;
    float* out; unsigned char* ws;
};
typedef const __attribute__((address_space(4))) Params CParams;

DI void p0_item_load(const float* W, int N, int item, int lane, f32x4 (&v)[8]) {
    const int nblk = N / 32, kb = item / nblk, nb = item % nblk, k0 = 64 * kb, n0 = 32 * nb;
#pragma unroll
    for (int i = 0; i < 8; ++i) v[i] = *(const f32x4*)(W + (size_t)(k0 + (lane >> 3) + 8 * i) * N + n0 + 4 * (lane & 7));
}
DI void p0_item_store(const f32x4 (&v)[8], const float* gain, int K, int N, bf16_t* WT, LAS float* scr, int item, int lane) {
    const int nblk = N / 32, kb = item / nblk, nb = item % nblk, k0 = 64 * kb, n0 = 32 * nb;
#pragma unroll
    for (int i = 0; i < 8; ++i) { const int kk = (lane >> 3) + 8 * i; f32x4 x = v[i]; if (gain) x = x * gain[k0 + kk]; LAS float* d = scr + kk * 33 + 4 * (lane & 7); d[0] = x.x; d[1] = x.y; d[2] = x.z; d[3] = x.w; }
    asm volatile("s_waitcnt lgkmcnt(0)" ::: "memory");
    const int c = lane & 7;
#pragma unroll
    for (int j = 0; j < 4; ++j) { const int n = (lane >> 3) + 8 * j; const LAS float* s = scr + (8 * c) * 33 + n;
        u32x4 o; o.x = pk2(s[0 * 33], s[1 * 33]); o.y = pk2(s[2 * 33], s[3 * 33]); o.z = pk2(s[4 * 33], s[5 * 33]); o.w = pk2(s[6 * 33], s[7 * 33]);
        *(u32x4*)(WT + (size_t)(n0 + n) * K + k0 + 8 * c) = o; }
    asm volatile("s_waitcnt lgkmcnt(0)" ::: "memory");
}
DI void p0_matrix(const float* W, const float* gain, int K, int N, bf16_t* WT, LAS float* scr, int nitems, int gw, int NGW, int lane) {
    for (int it = gw; it < nitems; it += 4 * NGW) {
        const int it2 = it + NGW, it3 = it + 2 * NGW, it4 = it + 3 * NGW; const bool h2 = it2 < nitems, h3 = it3 < nitems, h4 = it4 < nitems;
        f32x4 va[8], vb[8], vc[8], vd[8];
        p0_item_load(W, N, it, lane, va);
        if (h2) p0_item_load(W, N, it2, lane, vb);
        if (h3) p0_item_load(W, N, it3, lane, vc);
        if (h4) p0_item_load(W, N, it4, lane, vd);
        p0_item_store(va, gain, K, N, WT, scr, it, lane);
        if (h2) p0_item_store(vb, gain, K, N, WT, scr, it2, lane);
        if (h3) p0_item_store(vc, gain, K, N, WT, scr, it3, lane);
        if (h4) p0_item_store(vd, gain, K, N, WT, scr, it4, lane);
    }
}
DI void convert_weights(CParams& P, int l, LAS unsigned char* lds, int gw, int NGW, int lane, int wave, int which = 7) {
    unsigned char* ws = P.ws;
    LAS float* scr = (LAS float*)(lds + wave * 16384);
    constexpr int I_IN = (DM / 64) * (NPROJ / 32), I_OUT = (DM / 64) * (DM / 32), I_KV = (DM / 64) * (NKV / 32);
    if (which & 1) p0_matrix(P.w_in + (size_t)l * DM * NPROJ, P.norm_g + l * DM, DM, NPROJ, (bf16_t*)(ws + WS_WIN) + (size_t)l * NPROJ * DM, scr, I_IN, gw, NGW, lane);
    if (which & 2) p0_matrix(P.w_out + (size_t)l * DM * DM, nullptr, DM, DM, (bf16_t*)(ws + WS_WOUT) + (size_t)l * DM * DM, scr, I_OUT, gw, NGW, lane);
    if (which & 4) p0_matrix(P.w_kv + (size_t)l * DM * NKV, P.mem_ng + l * DM, DM, NKV, (bf16_t*)(ws + WS_WKV) + (size_t)l * NKV * DM, scr, I_KV, gw, NGW, lane);
}
DI void prologue(CParams& P, LAS unsigned char* lds, int vcu, int G, int tid, int lane, int wave) {
    unsigned char* ws = P.ws;
    const int gw = vcu * NWAVES + wave, NGW = G * NWAVES;
    convert_weights(P, 0, lds, gw, NGW, lane, wave);
    for (int m = gw; m < MTOK + MROWS; m += NGW) {
        const bool is_x = m < MTOK; const int row = is_x ? m : m - MTOK;
        const f32x4* xr = (const f32x4*)((is_x ? P.x : P.mem) + (size_t)row * DM) + lane;
        f32x4 v[16]; float s = 0.f;
#pragma unroll
        for (int j = 0; j < 16; ++j) { v[j] = xr[64 * j]; s += (v[j].x * v[j].x + v[j].y * v[j].y) + (v[j].z * v[j].z + v[j].w * v[j].w); }
        s = wave_sum(s);
        float sc = 1.f;
        if (is_x) { if (lane == 0) ((float*)(ws + WS_RSS0))[row] = s; } else sc = rsqrtf(s * (1.f / DM) + EPS);
        u32x2* o8 = (u32x2*)((bf16_t*)(ws + (is_x ? WS_XB : WS_MEMB)) + (size_t)row * DM) + lane;
#pragma unroll
        for (int j = 0; j < 16; ++j) { u32x2 w; w.x = pk2(v[j].x * sc, v[j].y * sc); w.y = pk2(v[j].z * sc, v[j].w * sc); o8[64 * j] = w; }
    }
    float* ct = (float*)(ws + WS_COS); float* st = (float*)(ws + WS_SIN);
    for (int i = vcu * NTHREADS + tid; i < MTOK * 128; i += G * NTHREADS) {
        const int j = i & 127, row = i >> 7;
        const float inv_freq = exp2f((float)j * (-13.287712379549449f / 128.f));
        const float ang = (float)P.pos[row] * inv_freq;
        double rev = (double)ang * 0.15915494309189535; rev -= __builtin_rint(rev);
        const float rf = (float)rev;
        ct[i] = __builtin_amdgcn_cosf(rf); st[i] = __builtin_amdgcn_sinf(rf);
    }
}

DI float reduce8(const float (&v)[8], int lane) {
    const bool h5 = lane & 32, h4 = lane & 16, h3 = lane & 8;
    float a[4], b2[2];
#pragma unroll
    for (int j = 0; j < 4; ++j) { const float keep = h5 ? v[4 + j] : v[j], send = h5 ? v[j] : v[4 + j]; a[j] = keep + __shfl_xor(send, 32); }
#pragma unroll
    for (int j = 0; j < 2; ++j) { const float keep = h4 ? a[2 + j] : a[j], send = h4 ? a[j] : a[2 + j]; b2[j] = keep + __shfl_xor(send, 16); }
    const float keep = h3 ? b2[1] : b2[0], send = h3 ? b2[0] : b2[1];
    float c = keep + __shfl_xor(send, 8);
    c += __shfl_xor(c, 4); c += __shfl_xor(c, 2); c += __shfl_xor(c, 1);
    return c;
}
DI float bcast_lane(float v, int srclane) { return __uint_as_float(__builtin_amdgcn_readlane(__float_as_uint(v), srclane)); }

DI void sgu_unit(CParams& P, int l, int u, LAS unsigned char* lds, int tid_, int lane_, int wave_) {
    int tid = tid_; asm volatile("" : "+v"(tid)); const int lane = tid & 63; const int wave = __builtin_amdgcn_readfirstlane(tid >> 6);
    const int g = u & 7, n = (u >> 3) & 15, b = u >> 7;
    const bf16_t* proj = (const bf16_t*)(P.ws + WS_PROJ) + (size_t)(b * SEQ + n * 128) * NPROJ;
    bf16_t* y = (bf16_t*)(P.ws + WS_Y) + (size_t)(b * SEQ + n * 128) * DM;
    constexpr int LD = 136, LDO = 132;
    LAS bf16_t* Wm = (LAS bf16_t*)lds; LAS bf16_t* Vn = (LAS bf16_t*)(lds + 34816); LAS float* Ot = (LAS float*)(lds + 69632);
    const float* sw = P.sgu_w + ((size_t)l * 8 + g) * 128 * 128;
    f32x4 wv[8]; u32x4 vv[4]; f32x2 av[4];
#pragma unroll
    for (int i = 0; i < 8; ++i) { const int idx = tid + NTHREADS * i, t = idx >> 5, s4 = (idx & 31) * 4; wv[i] = *(const f32x4*)(sw + t * 128 + s4); }
#pragma unroll
    for (int i = 0; i < 4; ++i) { const int idx = tid + NTHREADS * i, s = idx >> 4, c8 = (idx & 15) * 8; vv[i] = *(const u32x4*)(proj + (size_t)s * NPROJ + C_AV + g * 128 + c8);
        av[i] = *(const f32x2*)((const float*)(P.ws + WS_AVSTAT) + ((size_t)l * MTOK + (size_t)(b * SEQ + n * 128 + s)) * 2); }
#pragma unroll
    for (int i = 0; i < 8; ++i) { const int idx = tid + NTHREADS * i, t = idx >> 5, s4 = (idx & 31) * 4; f32x4 w = wv[i];
        if (s4 + 0 > t) w.x = 0.f; if (s4 + 1 > t) w.y = 0.f; if (s4 + 2 > t) w.z = 0.f; if (s4 + 3 > t) w.w = 0.f;
        u32x2 o; o.x = pk2(w.x, w.y); o.y = pk2(w.z, w.w); *(LAS u32x2*)(Wm + t * LD + s4) = o; }
    const float* ng = P.sgu_ng + l * GW + g * 128; const float* nbp = P.sgu_nb + l * GW + g * 128;
#pragma unroll
    for (int i = 0; i < 4; ++i) { const int idx = tid + NTHREADS * i, s = idx >> 4, c8 = (idx & 15) * 8;
        float f[8]; unpack8(vv[i], f); const float mean = av[i].x * (1.f / GW), var = av[i].y * (1.f / GW) - mean * mean, rstd = rsqrtf(fmaxf(var, 0.f) + EPS);
        const f32x4 g0 = *(const f32x4*)(ng + c8), g1 = *(const f32x4*)(ng + c8 + 4), b0 = *(const f32x4*)(nbp + c8), b1 = *(const f32x4*)(nbp + c8 + 4);
        const float gg[8] = {g0.x, g0.y, g0.z, g0.w, g1.x, g1.y, g1.z, g1.w}, bb[8] = {b0.x, b0.y, b0.z, b0.w, b1.x, b1.y, b1.z, b1.w};
#pragma unroll
        for (int j = 0; j < 8; ++j) f[j] = (f[j] - mean) * rstd * gg[j] + bb[j];
        *(LAS u32x4*)(Vn + s * LD + c8) = pack8f(f); }
    u32x4 uu[4], gt[4];
#pragma unroll
    for (int i = 0; i < 4; ++i) { const int idx = tid + NTHREADS * i, t = idx >> 4, c8 = (idx & 15) * 8; const bf16_t* pr = proj + (size_t)t * NPROJ + g * 128 + c8;
        uu[i] = *(const u32x4*)(pr + C_AU); gt[i] = *(const u32x4*)(pr + C_AG); }
    __syncthreads();
    { const int tt = wave >> 1, ct0 = (wave & 1) * 2;
      f32x16 acc[2]; acc[0] = zero16(); acc[1] = zero16();
      for (int ks = 0; ks < 2 * (tt + 1); ++ks) { const bf16x8 a = frag_row(Wm, LD, 32 * tt, 16 * ks, lane);
#pragma unroll
          for (int j = 0; j < 2; ++j) { const bf16x8 bb = frag_tr(Vn, LD, 16 * ks, 32 * (ct0 + j), lane); acc[j] = MFMA32(a, bb, acc[j]); } }
      const int r = lane & 31, h = lane >> 5;
#pragma unroll
      for (int j = 0; j < 2; ++j)
#pragma unroll
          for (int i = 0; i < 16; ++i) Ot[(32 * tt + crow(i, h)) * LDO + 32 * (ct0 + j) + r] = acc[j][i]; }
    __syncthreads();
    const float* sb = P.sgu_b + ((size_t)l * 8 + g) * 128;
#pragma unroll
    for (int i = 0; i < 4; ++i) { const int idx = tid + NTHREADS * i, t = idx >> 4, c8 = (idx & 15) * 8;
        const f32x4 o0 = *(const LAS f32x4*)(Ot + t * LDO + c8), o1 = *(const LAS f32x4*)(Ot + t * LDO + c8 + 4); const float bt = sb[t];
        float fu[8], fg[8], o[8]; unpack8(uu[i], fu); unpack8(gt[i], fg);
        const float ov[8] = {o0.x, o0.y, o0.z, o0.w, o1.x, o1.y, o1.z, o1.w};
#pragma unroll
        for (int j = 0; j < 8; ++j) o[j] = fu[j] * (ov[j] + bt) * silu_f(fg[j]);
        *(u32x4*)(y + (size_t)t * DM + g * 128 + c8) = pack8f(o); }
    __syncthreads();
}

DI void conv_unit(CParams& P, int l, int u, LAS unsigned char* lds, int tid_, int lane_, int wave_) {
    int tid = tid_; asm volatile("" : "+v"(tid)); const int lane = tid & 63; const int wave = __builtin_amdgcn_readfirstlane(tid >> 6);
    const int cgp = u & 7, stl = (u >> 3) & 15, b = u >> 7; const int s0 = stl * 128;
    const bf16_t* proj = (const bf16_t*)(P.ws + WS_PROJ) + (size_t)(b * SEQ) * NPROJ;
    bf16_t* y = (bf16_t*)(P.ws + WS_Y) + (size_t)(b * SEQ) * DM;
    LAS float* glu = (LAS float*)lds;
    u32x4 ra[5], rb[5];
#pragma unroll
    for (int i = 0; i < 5; ++i) { int idx = tid + NTHREADS * i; idx = idx < 158 * 16 ? idx : 158 * 16 - 1; const int sl = idx >> 4, c8 = (idx & 15) * 8; int sg = s0 - 30 + sl; sg = sg > 0 ? sg : 0;
        const bf16_t* pr = proj + (size_t)sg * NPROJ + cgp * 128 + c8; ra[i] = *(const u32x4*)(pr + C_BA); rb[i] = *(const u32x4*)(pr + C_BB); }
#pragma unroll
    for (int i = 0; i < 5; ++i) { const int idx = tid + NTHREADS * i;
        if (idx < 158 * 16) { const int sl = idx >> 4, c8 = (idx & 15) * 8, sg = s0 - 30 + sl; float a[8], bb[8], o[8]; unpack8(ra[i], a); unpack8(rb[i], bb);
#pragma unroll
            for (int j = 0; j < 8; ++j) { o[j] = a[j] * sigm_f(bb[j]); if (sg < 0) o[j] = 0.f; }
            *(LAS f32x4*)(glu + sl * 128 + c8) = (f32x4){o[0], o[1], o[2], o[3]}; *(LAS f32x4*)(glu + sl * 128 + c8 + 4) = (f32x4){o[4], o[5], o[6], o[7]}; } }
    const float* cw = P.conv_w + (size_t)l * 31 * GW + cgp * 128 + 2 * lane;
    f32x2 w[31];
    { const float* cwj = cw;
#pragma unroll
      for (int j = 0; j < 31; ++j) { w[j] = *(const f32x2*)cwj; cwj += GW; asm volatile("" : "+v"(cwj)); } }
    const f32x2 bias = *(const f32x2*)(P.conv_b + l * GW + cgp * 128 + 2 * lane);
    const f32x2 gn = *(const f32x2*)(P.conv_ng + l * GW + cgp * 128 + 2 * lane), gb = *(const f32x2*)(P.conv_nb + l * GW + cgp * 128 + 2 * lane);
    __syncthreads();
#pragma unroll 1
    for (int bb = 0; bb < 2; ++bb) { const int t0 = wave * 16 + bb * 8;
        unsigned gt[8];
#pragma unroll
        for (int i = 0; i < 8; ++i) gt[i] = *(const unsigned*)(proj + (size_t)(s0 + t0 + i) * NPROJ + C_BG + cgp * 128 + 2 * lane);
        f32x2 x[38];
#pragma unroll
        for (int r = 0; r < 38; ++r) x[r] = *(const LAS f32x2*)(glu + (t0 + r) * 128 + 2 * lane);
        f32x2 acc[8];
#pragma unroll
        for (int i = 0; i < 8; ++i) { acc[i] = bias;
#pragma unroll
            for (int j = 0; j < 31; ++j) acc[i] += w[j] * x[i + j]; }
        float ps[8], pss[8];
#pragma unroll
        for (int i = 0; i < 8; ++i) { ps[i] = acc[i].x + acc[i].y; pss[i] = acc[i].x * acc[i].x + acc[i].y * acc[i].y; }
        const float S1 = reduce8(ps, lane), S2 = reduce8(pss, lane);
        const float mean_l = S1 * (1.f / 128.f), var_l = S2 * (1.f / 128.f) - mean_l * mean_l, rstd_l = rsqrtf(fmaxf(var_l, 0.f) + EPS);
#pragma unroll
        for (int i = 0; i < 8; ++i) { const float mean = bcast_lane(mean_l, 8 * i), rstd = bcast_lane(rstd_l, 8 * i);
            const float a0 = (acc[i].x - mean) * rstd * gn.x + gb.x, a1 = (acc[i].y - mean) * rstd * gn.y + gb.y;
            *(unsigned*)(y + (size_t)(s0 + t0 + i) * DM + 1024 + cgp * 128 + 2 * lane) = pk2(silu_f(a0) * silu_f(bflo(gt[i])), silu_f(a1) * silu_f(bfhi(gt[i]))); } }
    __syncthreads();
}

DI void mem_unit(CParams& P, int l, int u, LAS unsigned char* lds, int tid_, int lane_, int wave_) {
    int tid = tid_; asm volatile("" : "+v"(tid)); const int lane = tid & 63; const int wave = __builtin_amdgcn_readfirstlane(tid >> 6);
    const int tt = u & 7, hh = (u >> 3) & 3, b = u >> 5;
    const bf16_t* proj = (const bf16_t*)(P.ws + WS_PROJ) + (size_t)(b * SEQ + tt * 256) * NPROJ;
    bf16_t* y = (bf16_t*)(P.ws + WS_Y) + (size_t)(b * SEQ + tt * 256) * DM;
    const bf16_t* kv = (const bf16_t*)(P.ws + WS_KV) + (size_t)(b * MEMLEN) * NKV + hh * 256;
    constexpr int LD = 136;
    LAS bf16_t* Kc = (LAS bf16_t*)lds; LAS bf16_t* Qc = (LAS bf16_t*)(lds + 69632); LAS bf16_t* Vc = (LAS bf16_t*)lds;
    f32x16 S[8];
#pragma unroll
    for (int i = 0; i < 8; ++i) S[i] = zero16();
    u32x4 ka[8], qa[8];
#define MEM_LOAD_KQ(rr) do { _Pragma("unroll") for (int i = 0; i < 8; ++i) { const int idx = tid + NTHREADS * i, m = idx >> 4, c8 = (idx & 15) * 8; \
        ka[i] = *(const u32x4*)(kv + (size_t)m * NKV + (rr) * 128 + c8); qa[i] = *(const u32x4*)(proj + (size_t)m * NPROJ + C_MQ + hh * 256 + (rr) * 128 + c8); } } while (0)
    MEM_LOAD_KQ(0);
#pragma unroll
    for (int rr = 0; rr < 2; ++rr) {
#pragma unroll
        for (int i = 0; i < 8; ++i) { const int idx = tid + NTHREADS * i, m = idx >> 4, c8 = (idx & 15) * 8; *(LAS u32x4*)(Kc + m * LD + c8) = ka[i]; *(LAS u32x4*)(Qc + m * LD + c8) = qa[i]; }
        if (rr == 0) MEM_LOAD_KQ(1);
        __syncthreads();
#pragma unroll
        for (int ks = 0; ks < 8; ++ks) { const bf16x8 bq = frag_row(Qc, LD, 32 * wave, 16 * ks, lane);
#pragma unroll
            for (int mt = 0; mt < 8; ++mt) { const bf16x8 a = frag_row(Kc, LD, 32 * mt, 16 * ks, lane); S[mt] = MFMA32(a, bq, S[mt]); } }
        __syncthreads();
    }
#undef MEM_LOAD_KQ
    u32x4 va[8];
#define MEM_LOAD_V(rr) do { _Pragma("unroll") for (int i = 0; i < 8; ++i) { const int idx = tid + NTHREADS * i, m = idx >> 4, c8 = (idx & 15) * 8; \
        va[i] = *(const u32x4*)(kv + (size_t)m * NKV + 1024 + (rr) * 128 + c8); } } while (0)
    MEM_LOAD_V(0);
    float mx = -3.0e38f;
#pragma unroll
    for (int mt = 0; mt < 8; ++mt)
#pragma unroll
        for (int i = 0; i < 16; ++i) mx = fmaxf(mx, S[mt][i]);
    mx = fmaxf(mx, __shfl_xor(mx, 32));
    const float cs = 1.4426950408889634f * 0.0625f; float sum = 0.f;
#pragma unroll
    for (int mt = 0; mt < 8; ++mt)
#pragma unroll
        for (int i = 0; i < 16; ++i) { const float p = exp2f((S[mt][i] - mx) * cs); S[mt][i] = p; sum += p; }
    sum += __shfl_xor(sum, 32);
    const float inv = 1.f / sum;
    bf16x8 Pk[8][2];
#pragma unroll
    for (int mt = 0; mt < 8; ++mt) { Pk[mt][0] = pack_acc<0>(S[mt]); Pk[mt][1] = pack_acc<1>(S[mt]); }
    const int r = lane & 31, h = lane >> 5; const int t = 32 * wave + r;
#pragma unroll
    for (int rr = 0; rr < 2; ++rr) {
#pragma unroll
        for (int i = 0; i < 8; ++i) { const int idx = tid + NTHREADS * i, m = idx >> 4, c8 = (idx & 15) * 8; *(LAS u32x4*)(Vc + m * LD + c8) = va[i]; }
        if (rr == 0) MEM_LOAD_V(1);
        u32x2 gw[4][4];
#pragma unroll
        for (int dt = 0; dt < 2; ++dt)
#pragma unroll
            for (int g4 = 0; g4 < 4; ++g4) gw[dt][g4] = *(const u32x2*)(proj + (size_t)t * NPROJ + C_MG + hh * 256 + rr * 128 + 32 * dt + 8 * g4 + 4 * h);
        __syncthreads();
        f32x16 O[4];
#pragma unroll
        for (int dt = 0; dt < 4; ++dt) O[dt] = zero16();
#pragma unroll
        for (int mt = 0; mt < 8; ++mt) { int ln = lane; asm volatile("" : "+v"(ln));
#pragma unroll
            for (int sx = 0; sx < 2; ++sx)
#pragma unroll
                for (int dt = 0; dt < 4; ++dt) { const bf16x8 a = frag_tr_perm(Vc, LD, 32 * mt + 16 * sx, 32 * dt, ln); O[dt] = MFMA32(a, Pk[mt][sx], O[dt]); }
            asm volatile("" : "+v"(O[0]), "+v"(O[1]), "+v"(O[2]), "+v"(O[3])); }
#pragma unroll
        for (int dt = 2; dt < 4; ++dt)
#pragma unroll
            for (int g4 = 0; g4 < 4; ++g4) gw[dt][g4] = *(const u32x2*)(proj + (size_t)t * NPROJ + C_MG + hh * 256 + rr * 128 + 32 * dt + 8 * g4 + 4 * h);
#pragma unroll
        for (int dt = 0; dt < 4; ++dt)
#pragma unroll
            for (int g4 = 0; g4 < 4; ++g4) { const int d = hh * 256 + rr * 128 + 32 * dt + 8 * g4 + 4 * h; const u32x2 gq = gw[dt][g4];
                const float o0 = O[dt][4 * g4 + 0] * inv * silu_f(bflo(gq.x)), o1 = O[dt][4 * g4 + 1] * inv * silu_f(bfhi(gq.x)), o2 = O[dt][4 * g4 + 2] * inv * silu_f(bflo(gq.y)), o3 = O[dt][4 * g4 + 3] * inv * silu_f(bfhi(gq.y));
                u32x2 w; w.x = pk2(o0, o1); w.y = pk2(o2, o3); *(u32x2*)(y + (size_t)t * DM + 3072 + d) = w; }
        __syncthreads();
    }
#undef MEM_LOAD_V
}

DI void ret_unit(CParams& P, int l, int u, LAS unsigned char* lds, int tid_, int lane_, int wave_) {
    int tid0 = tid_; asm volatile("" : "+v"(tid0)); const int wave = __builtin_amdgcn_readfirstlane(tid0 >> 6);
#define RET_FRESH() int tid = tid0; asm volatile("" : "+v"(tid)); const int lane = tid & 63, r = lane & 31, h = lane >> 5; (void)r; (void)h; (void)tid
    const int hh = u & 3, b = u >> 2;
    constexpr int LD = 264, LDP = 72, LDR = 256, IMG = 33792;
    LAS bf16_t* Qs = (LAS bf16_t*)lds; LAS bf16_t* Ks = (LAS bf16_t*)(lds + IMG); LAS bf16_t* Vs = (LAS bf16_t*)(lds + 2 * IMG);
    LAS bf16_t* Ps = (LAS bf16_t*)(lds + 3 * IMG); LAS bf16_t* R = (LAS bf16_t*)(lds + 3 * IMG + 9216);
    const float g64 = exp2f(64.f * log2f(1.f - exp2f(-5.f - (float)hh)));
    const float* ng = P.ret_ng + l * GW + hh * 256; const float* nbp = P.ret_nb + l * GW + hh * 256;
    f32x16 St[8];
#pragma unroll
    for (int i = 0; i < 8; ++i) St[i] = zero16();
#define RET_DMA(img, nn) do { const char* pj_ = (const char*)((const bf16_t*)(P.ws + WS_PROJ) + (size_t)(b * SEQ + (nn) * 64) * NPROJ + hh * 256 + ((img) == 0 ? C_CQ : ((img) == 1 ? C_CK : C_CV))); \
        _Pragma("unroll 1") for (int j = wave; j < 33; j += 8) { const int q = 64 * j + lane, row = q / 33, ch = q - row * 33; \
            const char* src = pj_ + (size_t)row * (NPROJ * 2) + (ch < 32 ? ch : 31) * 16; \
            __builtin_amdgcn_global_load_lds((const unsigned*)src, (LAS unsigned*)(lds + (img) * IMG + j * 1024), 16, 0, 0); } } while (0)
#define RET_VMWAIT() asm volatile("s_waitcnt vmcnt(0)" ::: "memory")
    { RET_FRESH(); RET_DMA(0, 0); RET_DMA(1, 0); RET_DMA(2, 0); }
    RET_VMWAIT();
    __syncthreads();
    for (int n = 0; n < 32; ++n) {
        const int rowbase = b * SEQ + n * 64;
        const bf16_t* proj = (const bf16_t*)(P.ws + WS_PROJ) + (size_t)rowbase * NPROJ;
        bf16_t* y = (bf16_t*)(P.ws + WS_Y) + (size_t)rowbase * DM;
        f32x16 C[2]; C[0] = zero16(); C[1] = zero16();
        u32x2 gate[8];
        {
        RET_FRESH();
#pragma unroll
        for (int dt = 0; dt < 8; ++dt) {
            int ln = lane; asm volatile("" : "+v"(ln));
            { const bf16x8 bS = pack_acc<0>(St[dt]);
#pragma unroll
              for (int ti = 0; ti < 2; ++ti) { const bf16x8 a = frag_row_perm(Qs, LD, 32 * ti, 32 * dt, ln); C[ti] = MFMA32(a, bS, C[ti]); } }
            { const bf16x8 bS = pack_acc<1>(St[dt]);
#pragma unroll
              for (int ti = 0; ti < 2; ++ti) { const bf16x8 a = frag_row_perm(Qs, LD, 32 * ti, 32 * dt + 16, ln); C[ti] = MFMA32(a, bS, C[ti]); } }
            asm volatile("" : "+v"(C[0]), "+v"(C[1]));
        }
#pragma unroll
        for (int ti = 0; ti < 2; ++ti)
#pragma unroll
            for (int i = 0; i < 16; ++i) C[ti][i] *= g64;
        }
        RET_VMWAIT();
        __syncthreads();
        if (wave < 4) { RET_FRESH(); const int ti = wave >> 1, si = wave & 1;
          f32x16 acc = zero16();
          if (si <= ti) {
#pragma unroll
              for (int ks = 0; ks < 16; ++ks) { const bf16x8 a = frag_row(Qs, LD, 32 * ti, 16 * ks, lane), bb = frag_row(Ks, LD, 32 * si, 16 * ks, lane); acc = MFMA32(a, bb, acc); } }
#pragma unroll
          for (int i = 0; i < 16; ++i) { const int t = 32 * ti + crow(i, h), s = 32 * si + r; float v = acc[i]; if (s > t) v = 0.f; Ps[t * LDP + s] = (bf16_t)f2bf(v); } }
        __syncthreads();
        {
        RET_FRESH();
        if (n + 1 < 32) RET_DMA(0, n + 1);
        bf16x8 bv[4];
#pragma unroll
        for (int ks = 0; ks < 4; ++ks) { bv[ks] = frag_tr(Vs, LD, 16 * ks, 32 * wave, lane);
#pragma unroll
            for (int ti = 0; ti < 2; ++ti) { const bf16x8 a = frag_row(Ps, LDP, 32 * ti, 16 * ks, lane); C[ti] = MFMA32(a, bv[ks], C[ti]); } }
#pragma unroll
        for (int ti = 0; ti < 2; ++ti)
#pragma unroll
            for (int i = 0; i < 16; ++i) R[(32 * ti + crow(i, h)) * LDR + 32 * wave + r] = (bf16_t)f2bf(C[ti][i]);
        asm volatile("" ::: "memory");
#pragma unroll
        for (int i = 0; i < 8; ++i) gate[i] = *(const u32x2*)(proj + (size_t)(wave * 8 + i) * NPROJ + C_CG + hh * 256 + 4 * lane);
#pragma unroll
        for (int dt = 0; dt < 8; ++dt) {
            int ln = lane; asm volatile("" : "+v"(ln));
#pragma unroll
            for (int i = 0; i < 16; ++i) St[dt][i] *= g64;
#pragma unroll
            for (int ks = 0; ks < 4; ++ks) { const bf16x8 a = frag_tr(Ks, LD, 16 * ks, 32 * dt, ln); St[dt] = MFMA32(a, bv[ks], St[dt]); }
            asm volatile("" : "+v"(St[dt])); }
        }
        RET_VMWAIT();
        __syncthreads();
        { RET_FRESH(); if (n + 1 < 32) { RET_DMA(1, n + 1); RET_DMA(2, n + 1); } }
        {
        RET_FRESH();
        float ps[8], pss[8];
#pragma unroll
        for (int i = 0; i < 8; ++i) { const u32x2 w = *(const LAS u32x2*)(R + (wave * 8 + i) * LDR + 4 * lane); const float v0 = bflo(w.x), v1 = bfhi(w.x), v2 = bflo(w.y), v3 = bfhi(w.y);
            ps[i] = (v0 + v1) + (v2 + v3); pss[i] = (v0 * v0 + v1 * v1) + (v2 * v2 + v3 * v3); }
        const float S1 = reduce8(ps, lane), S2 = reduce8(pss, lane);
        const float mean_l = S1 * (1.f / 256.f), var_l = S2 * (1.f / 256.f) - mean_l * mean_l, rstd_l = rsqrtf(fmaxf(var_l, 0.f) + EPS);
        const f32x4 gn = *(const f32x4*)(ng + 4 * lane), gb = *(const f32x4*)(nbp + 4 * lane);
#pragma unroll
        for (int i = 0; i < 8; ++i) { const float mean = bcast_lane(mean_l, 8 * i), rstd = bcast_lane(rstd_l, 8 * i);
            const u32x2 w2 = *(const LAS u32x2*)(R + (wave * 8 + i) * LDR + 4 * lane); const float v0 = bflo(w2.x), v1 = bfhi(w2.x), v2 = bflo(w2.y), v3 = bfhi(w2.y);
            const float g0 = bflo(gate[i].x), g1 = bfhi(gate[i].x), g2 = bflo(gate[i].y), g3 = bfhi(gate[i].y);
            const float o0 = ((v0 - mean) * rstd * gn.x + gb.x) * silu_f(g0), o1 = ((v1 - mean) * rstd * gn.y + gb.y) * silu_f(g1);
            const float o2 = ((v2 - mean) * rstd * gn.z + gb.z) * silu_f(g2), o3 = ((v3 - mean) * rstd * gn.w + gb.w) * silu_f(g3);
            u32x2 w; w.x = pk2(o0, o1); w.y = pk2(o2, o3); *(u32x2*)(y + (size_t)(wave * 8 + i) * DM + 2048 + hh * 256 + 4 * lane) = w; }
        }
    }
    RET_VMWAIT();
    __syncthreads();
#undef RET_FRESH
#undef RET_DMA
#undef RET_VMWAIT
}


#define XB_TMO      128
#define XB_XCNT(j)  (256  + 64 * (j))
#define XB_XSUB(j)  (1280 + 64 * (j))
#define XB_XGEN(j)  (2304 + 64 * (j))
#define XB_TOP      3328
#define XB_TOPGEN   3392
#define XCD_BAR_WORDS 3456
#define XB_SPIN_CAP (1u << 18)
DI unsigned xb_ld(unsigned* p)              { return __hip_atomic_load(p, __ATOMIC_RELAXED, __HIP_MEMORY_SCOPE_AGENT); }
DI unsigned xb_add(unsigned* p, unsigned v) { return __hip_atomic_fetch_add(p, v, __ATOMIC_RELAXED, __HIP_MEMORY_SCOPE_AGENT); }
DI unsigned xb_xcc_id() { return (unsigned)__builtin_amdgcn_s_getreg((3 << 11) | 20) & 0xFu; }
#define XB_SPIN(cond, bar) do { unsigned _sp = 0; while (cond) { __builtin_amdgcn_s_sleep(1); \
    if ((++_sp & 255u) == 0u) { if (xb_ld(&(bar)[XB_TMO])) break; if (_sp > XB_SPIN_CAP) { atomicAdd(&(bar)[XB_TMO], 1u); break; } } } } while (0)
struct XcdBarrier { unsigned* bar; unsigned x; volatile LAS unsigned* st; };
DI XcdBarrier xcd_barrier_post(unsigned* bar, volatile LAS unsigned* st) {
    XcdBarrier b; b.bar = bar; b.x = xb_xcc_id(); b.st = st;
    if (threadIdx.x == 0) (void)xb_add(&bar[XB_XCNT(b.x)], 1u);
    return b;
}
DI void xcd_barrier_complete(unsigned* bar, unsigned x, unsigned& nloc, unsigned& nx) {
    const unsigned G = gridDim.x * gridDim.y * gridDim.z;
    unsigned sum, cnt, mine, sp = 0u;
    for (;;) {
        sum = 0u; cnt = 0u; mine = 0u;
#pragma unroll
        for (unsigned j = 0; j < 16; ++j) { const unsigned c = xb_ld(&bar[XB_XCNT(j)]); sum += c; cnt += (c > 0u) ? 1u : 0u; mine = (j == x) ? c : mine; }
        if (sum == G) break;
        __builtin_amdgcn_s_sleep(1);
        if ((++sp & 255u) == 0u) { if (xb_ld(&bar[XB_TMO])) break; if (sp > XB_SPIN_CAP) { atomicAdd(&bar[XB_TMO], 1u); break; } }
    }
    nloc = mine > 0u ? mine : 1u; nx = cnt > 0u ? cnt : 1u;
}
DI void xcd_barrier(const XcdBarrier& b) {
    asm volatile("s_waitcnt vmcnt(0)" ::: "memory");
    __syncthreads();
    if (threadIdx.x == 0) {
        unsigned* bar = b.bar; unsigned bx_ = b.x; asm volatile("" : "+s"(bx_), "+s"(bar));
        __builtin_amdgcn_s_waitcnt(0);
        unsigned nloc = b.st[0], nx = b.st[1];
        if (nloc == 0u) { xcd_barrier_complete(bar, bx_, nloc, nx); b.st[0] = nloc; b.st[1] = nx; }
        const unsigned old = xb_add(&bar[XB_XSUB(bx_)], 1u);
        const unsigned gen = old / nloc;
        if (old + 1u == (gen + 1u) * nloc) {
            __builtin_amdgcn_fence(__ATOMIC_RELEASE, "agent");
            asm volatile("s_waitcnt vmcnt(0)" ::: "memory");
            const unsigned og = xb_add(&bar[XB_TOP], 1u);
            const unsigned tg = og / nx;
            if (og + 1u == (tg + 1u) * nx) xb_add(&bar[XB_TOPGEN], 1u);
            else XB_SPIN(xb_ld(&bar[XB_TOPGEN]) == tg, bar);
            __builtin_amdgcn_fence(__ATOMIC_ACQUIRE, "agent");
            xb_add(&bar[XB_XGEN(bx_)], 1u);
            asm volatile("s_waitcnt vmcnt(0)" ::: "memory");
        } else {
            XB_SPIN(xb_ld(&bar[XB_XGEN(bx_)]) == gen, bar);
            __builtin_amdgcn_fence(__ATOMIC_ACQUIRE, "agent");
            asm volatile("s_waitcnt vmcnt(0)" ::: "memory");
        }
    }
    __syncthreads();
}

__global__ void __launch_bounds__(NTHREADS, 2) fwd_megakernel(Params P_) {
    CParams* const kp = (CParams*)__builtin_amdgcn_kernarg_segment_ptr();
#define P (*({ CParams* q_ = kp; asm volatile("" : "+s"(q_)); q_; }))
    extern __shared__ __attribute__((aligned(16))) unsigned char lds_raw[];
    cg::grid_group grid = cg::this_grid();
    LAS unsigned char* lds = (LAS unsigned char*)lds_raw;
    volatile LAS int* misc = (volatile LAS int*)(lds + LDS_MAIN);
#define tid ((int)threadIdx.x)
#define lane (tid & 63)
#define wave (__builtin_amdgcn_readfirstlane(tid >> 6))
    const int G = gridDim.x, bx = blockIdx.x; const int vcu = (G % 8 == 0) ? (bx % 8) * (G / 8) + bx / 8 : bx;
    unsigned char* ws = P.ws;
    if (tid < 16) misc[tid] = 0;
    __syncthreads();
    const XcdBarrier xbar = xcd_barrier_post((unsigned*)(ws + WS_CTL) + 4096, (volatile LAS unsigned*)(misc + 8));

#ifndef NO_PRO
    prologue(P, lds, vcu, G, tid, lane, wave);
#endif
    if (G == 0x7fffffff) grid.sync();
    xcd_barrier(xbar);

    _Pragma("unroll") for (int l = 0; l < DEPTH; ++l) {
        const float* rss_in = (const float*)(ws + (l == 0 ? WS_RSS0 : WS_RSS1));
        float* rss_out = (float*)(ws + (l == 0 ? WS_RSS1 : WS_RSS2));
        const pg8::Gemm g_in{(const bf16_t*)(ws + WS_XB), (const bf16_t*)(ws + WS_WIN) + (size_t)l * NPROJ * DM, MTOK, NPROJ, DM};
        const pg8::EpiProj E_in{(bf16_t*)(ws + WS_PROJ), NPROJ, rss_in, 1.f / DM, EPS, 1, (const float*)(ws + WS_COS), (const float*)(ws + WS_SIN), (float*)(ws + WS_AVSTAT) + (size_t)l * MTOK * 2};
        { const pg8::SubOrder S{16, 1024, 16, 24, 24, bx, G, 0};
          pg8::gemm_phase<pg8::EpiProj, pg8::SubOrder, true, true>(lds, g_in, S, E_in); }
        xcd_barrier(xbar);
#ifndef NO_RET
        if (bx < 32) ret_unit(P, l, bx, lds, tid, lane, wave);
#endif
        { const pg8::SubOrder S{32, 2048, 24, 0, 16, bx, G, 1};
          pg8::gemm_phase<pg8::EpiProj, pg8::SubOrder, true, true>(lds, g_in, S, E_in); }
        { pg8::Gemm g{(const bf16_t*)(ws + WS_MEMB), (const bf16_t*)(ws + WS_WKV) + (size_t)l * NKV * DM, MROWS, NKV, DM}; pg8::StaticOrder S; S.init(MROWS, NKV, G, (bx >= 96 && bx < 160) ? bx - 96 : (1 << 20));
          pg8::EpiProj E{(bf16_t*)(ws + WS_KV), NKV, nullptr, 0.f, 0.f, 0, nullptr, nullptr, nullptr};
          pg8::gemm_phase<pg8::EpiProj, pg8::StaticOrder, true, true>(lds, g, S, E); }
        if (bx >= 160) { int t2 = threadIdx.x; asm volatile("" : "+v"(t2)); const int w2 = __builtin_amdgcn_readfirstlane(t2 >> 6);
            convert_weights(P, 1, lds, (bx - 160) * NWAVES + w2, 96 * NWAVES, t2 & 63, w2, l == 0 ? 5 : 2); }
        xcd_barrier(xbar);
        { unsigned* ctr = (unsigned*)(ws + WS_CTL) + 64 * l;
          for (;;) {
              __syncthreads();
              if (tid == 0) misc[0] = (int)atomicAdd(ctr, 1u);
              __syncthreads();
              const int u = misc[0];
              if (u >= 256 + 1024 + 1024) break;
              if (u < 256) mem_unit(P, l, u, lds, tid, lane, wave);
              else if (u < 256 + 1024) sgu_unit(P, l, u - 256, lds, tid, lane, wave);
              else conv_unit(P, l, u - 1280, lds, tid, lane, wave);
          } }
        xcd_barrier(xbar);
        { pg8::Gemm g{(const bf16_t*)(ws + WS_Y), (const bf16_t*)(ws + WS_WOUT) + (size_t)l * DM * DM, MTOK, DM, DM}; pg8::StaticOrder S; S.init(MTOK, DM, G, bx);
          pg8::EpiRes E{l == 0 ? P.x : (const float*)nullptr, (bf16_t*)(ws + WS_XB), rss_out, DM};
          pg8::gemm_phase<pg8::EpiRes, pg8::StaticOrder, true, true>(lds, g, S, E); }
        xcd_barrier(xbar);
    }
#undef tid
#undef lane
#undef wave
    { int t2 = threadIdx.x; asm volatile("" : "+v"(t2)); const int lane = t2 & 63, wave = __builtin_amdgcn_readfirstlane(t2 >> 6);
      const int gw = vcu * NWAVES + wave, NGW = G * NWAVES; const float* rss = (const float*)(ws + WS_RSS2);
      const f32x4* gr = (const f32x4*)P.fin_g + 2 * lane; float* outp = P.out;
      for (int m = gw; m < MTOK; m += NGW) { const float rstd = rsqrtf(rss[m] * (1.f / DM) + EPS);
          const u32x4* xr = (const u32x4*)((const bf16_t*)(ws + WS_XB) + (size_t)m * DM) + lane; f32x4* orow = (f32x4*)(outp + (size_t)m * DM) + 2 * lane;
          u32x4 xv[8];
#pragma unroll
          for (int j = 0; j < 8; ++j) xv[j] = __builtin_nontemporal_load(xr + 64 * j);
#pragma unroll
          for (int j = 0; j < 8; ++j) { float f[8]; unpack8(xv[j], f); const f32x4 g0 = gr[128 * j], g1 = gr[128 * j + 1];
              __builtin_nontemporal_store((f32x4){f[0], f[1], f[2], f[3]} * rstd * g0, orow + 128 * j); __builtin_nontemporal_store((f32x4){f[4], f[5], f[6], f[7]} * rstd * g1, orow + 128 * j + 1); } } }
}

#undef P
extern "C" void kernel_launch(void* const* d_in, const int* in_sizes, int n_in, void* d_out, int out_size, void* d_ws, size_t ws_size, hipStream_t stream) {
    static int grid = 0;
    if (grid == 0) {
        if (n_in != 19 || in_sizes[0] != MTOK * DM || out_size != MTOK * DM || ws_size < WS_END) { fprintf(stderr, "kernel_launch: unexpected shapes (n_in %d, in0 %d, out %d, ws %zu < %zu)\n", n_in, n_in > 0 ? in_sizes[0] : -1, out_size, ws_size, (size_t)WS_END); grid = -1; return; }
        int dev = 0, cus = 0, per_cu = 0;
        if (hipGetDevice(&dev) != hipSuccess || hipDeviceGetAttribute(&cus, hipDeviceAttributeMultiprocessorCount, dev) != hipSuccess) { grid = -1; return; }
        if (hipFuncSetAttribute((const void*)fwd_megakernel, hipFuncAttributeMaxDynamicSharedMemorySize, LDS_BYTES) != hipSuccess) { fprintf(stderr, "kernel_launch: hipFuncSetAttribute failed\n"); grid = -1; return; }
        if (hipOccupancyMaxActiveBlocksPerMultiprocessor(&per_cu, (const void*)fwd_megakernel, NTHREADS, LDS_BYTES) != hipSuccess || per_cu < 1) { fprintf(stderr, "kernel_launch: occupancy query says %d\n", per_cu); per_cu = 1; }
        (void)hipGetLastError();
        grid = cus * per_cu;
        if (grid != 256) { fprintf(stderr, "kernel_launch: this kernel's phase program is laid out for a 256-workgroup grid (256 CUs x 1); got %d x %d\n", cus, per_cu); grid = -1; return; }
    }
    if (grid < 0) return;
    if (hipMemsetAsync((char*)d_ws + WS_CTL, 0, CTL_ZERO_BYTES, stream) != hipSuccess) { fprintf(stderr, "kernel_launch: memset failed\n"); return; }
    Params p{};
    p.x = (const float*)d_in[0]; p.mem = (const float*)d_in[1]; p.pos = (const int*)d_in[2]; p.norm_g = (const float*)d_in[3]; p.w_in = (const float*)d_in[4];
    p.sgu_ng = (const float*)d_in[5]; p.sgu_nb = (const float*)d_in[6]; p.sgu_w = (const float*)d_in[7]; p.sgu_b = (const float*)d_in[8];
    p.conv_w = (const float*)d_in[9]; p.conv_b = (const float*)d_in[10]; p.conv_ng = (const float*)d_in[11]; p.conv_nb = (const float*)d_in[12];
    p.ret_ng = (const float*)d_in[13]; p.ret_nb = (const float*)d_in[14]; p.mem_ng = (const float*)d_in[15]; p.w_kv = (const float*)d_in[16]; p.w_out = (const float*)d_in[17]; p.fin_g = (const float*)d_in[18];
    p.out = (float*)d_out; p.ws = (unsigned char*)d_ws;
    void* args[] = {&p};
    hipError_t e = hipLaunchCooperativeKernel((const void*)fwd_megakernel, dim3(grid), dim3(NTHREADS), args, LDS_BYTES, stream);
    if (e != hipSuccess) fprintf(stderr, "kernel_launch: cooperative launch failed: %s (grid %d)\n", hipGetErrorString(e), grid);
}
```

```cpp
#include <hip/hip_runtime.h>
#include <hip/hip_cooperative_groups.h>
#include <cstdio>
#include <cstdint>
namespace cg = cooperative_groups;

#define DI __device__ __forceinline__
#define LAS __attribute__((address_space(3)))
typedef unsigned short bf16_t;
typedef short bf16x8 __attribute__((ext_vector_type(8)));
typedef short s16x4 __attribute__((ext_vector_type(4)));
typedef float f32x4 __attribute__((ext_vector_type(4)));
typedef float f32x2 __attribute__((ext_vector_type(2)));
typedef float f32x16 __attribute__((ext_vector_type(16)));
typedef unsigned u32x4 __attribute__((ext_vector_type(4)));
typedef unsigned u32x2 __attribute__((ext_vector_type(2)));

namespace pg8 {
constexpr int BM = 256, BK = 64, HALF = 128, HTB = HALF * BK * 2, STAGE_BYTES = 8 * HTB, NXCD = 8, WGM = 8;
__host__ __device__ __forceinline__ int lds_byte(int r, int c) { const int st = (r >> 4) * 2 + (c >> 5), rr = r & 15, cc = c & 31, ob = rr * 64 + cc * 2; return st * 1024 + (ob ^ (((ob >> 9) & 1) << 5)); }
__host__ __device__ __forceinline__ void stage_rc(int b, int& R, int& C) { const int st = b / 1024, sb = b % 1024, swz = sb ^ (((sb >> 9) & 1) << 5); R = (st >> 1) * 16 + swz / 64; C = (st & 1) * 32 + (swz % 64) / 2; }
__host__ __device__ __forceinline__ int perm32(int rho) { const int n = rho >> 4, i = rho & 15; return 8 * (i >> 2) + 4 * n + (i & 3); }
struct Unit { int pm, pn; };
struct Gemm { const bf16_t* A; const bf16_t* Bt; int M, N, K; };
struct StaticOrder {
    int nM, nN, nwg, G, c;
    __host__ __device__ void init(int M, int N, int G_, int c_) { nM = M / BM; nN = N / BM; nwg = nM * nN; G = G_; c = c_; }
    __host__ __device__ bool next(int i, Unit& u) const {
        const long L = (long)i * G + c; if (L >= nwg) return false;
        int wgid = (int)L; { const int q = nwg / NXCD, r = nwg % NXCD, xcd = wgid % NXCD, off = wgid / NXCD; wgid = (xcd < r ? xcd * (q + 1) : r * (q + 1) + (xcd - r) * q) + off; }
        const int nig = WGM * nN, gid = wgid / nig, fm = gid * WGM, gsz = (nM - fm) < WGM ? (nM - fm) : WGM;
        u.pm = fm + ((wgid % nig) % gsz); u.pn = (wgid % nig) / gsz; return true;
    }
    __device__ __forceinline__ void a_ready(const Unit&) const {}
    __device__ __forceinline__ void done(const Unit&) const {}
};
struct SubOrder {
    int nNv, nwg, split, off0, off1, c, G, mode;
    __device__ __forceinline__ bool next(int i, Unit& u) const {
        int L;
        if (mode == 0) { L = i * G + c; if (L >= nwg) return false; }
        else if (c >= 32) { if (i < 8) L = i * 224 + (c - 32); else if (i == 8 && c < 96) L = 1984 + (c - 32); else return false; }
        else { if (i < 6) L = 1792 + i * 32 + c; else return false; }
        int wgid = L; { const int q = nwg / NXCD, xcd = wgid % NXCD, off = wgid / NXCD; wgid = xcd * q + off; }
        const int nig = WGM * nNv, gid = wgid / nig; const int pv = (wgid % nig) / WGM;
        u.pm = gid * WGM + ((wgid % nig) % WGM); u.pn = pv < split ? pv + off0 : pv + off1; return true;
    }
    __device__ __forceinline__ void a_ready(const Unit&) const {}
    __device__ __forceinline__ void done(const Unit&) const {}
};
__device__ __forceinline__ unsigned cvt_pk_bf16(float lo, float hi) { unsigned r; asm volatile("v_cvt_pk_bf16_f32 %0, %1, %2" : "=v"(r) : "v"(lo), "v"(hi)); return r; }

struct EpiProj {
    static constexpr bool PERM = true, AFTER_DRAIN = false;
    bf16_t* O; int ldc; const float* rss; float invk, eps; int mode; const float* ctab; const float* stab; float* avstat;
    __device__ __forceinline__ void operator()(const f32x4 (&acc)[2][2][4][2], const Unit& u, int wr, int wc, int fr, int fq) const {
        const int row0 = u.pm * BM + wr * 64 + fr; const int col0 = u.pn * BM + wc * 32 + 8 * fq;
        const bool rot = mode == 1 && u.pn >= 24 && u.pn < 32, stat = mode == 1 && u.pn >= 4 && u.pn < 8;
        float lg2 = 0.f, kmul = 1.f;
        if (rot) { const int hd = (u.pn - 24) & 3; lg2 = log2f(1.f - exp2f(-5.f - (float)hd)); if (u.pn >= 28) { lg2 = -lg2; kmul = 0.0625f; } }
#pragma unroll
        for (int ai = 0; ai < 2; ++ai)
#pragma unroll
            for (int m = 0; m < 4; ++m) { const int row = row0 + ai * HALF + m * 16; bf16_t* rowp = O + (size_t)row * ldc + col0;
                float sc = 1.f; if (rss) sc = rsqrtf(rss[row] * invk + eps);
                f32x4 v[2][2];
#pragma unroll
                for (int bj = 0; bj < 2; ++bj)
#pragma unroll
                    for (int n = 0; n < 2; ++n) v[bj][n] = acc[ai][bj][m][n] * sc;
                if (rot) { const float f = exp2f((float)(row & 63) * lg2) * kmul; const int j0 = wc * 32 + 8 * fq;
#pragma unroll
                    for (int n = 0; n < 2; ++n) { const f32x4 cs = *(const f32x4*)(ctab + (size_t)row * 128 + j0 + 4 * n), sn = *(const f32x4*)(stab + (size_t)row * 128 + j0 + 4 * n);
                        const f32x4 x1 = v[0][n], x2 = v[1][n]; v[0][n] = (x1 * cs - x2 * sn) * f; v[1][n] = (x2 * cs + x1 * sn) * f; } }
                if (stat) { float s1 = 0.f, s2 = 0.f;
#pragma unroll
                    for (int bj = 0; bj < 2; ++bj)
#pragma unroll
                        for (int n = 0; n < 2; ++n) { const f32x4 x = v[bj][n]; s1 += (x[0] + x[1]) + (x[2] + x[3]); s2 += (x[0] * x[0] + x[1] * x[1]) + (x[2] * x[2] + x[3] * x[3]); }
                    s1 += __shfl_xor(s1, 16); s1 += __shfl_xor(s1, 32); s2 += __shfl_xor(s2, 16); s2 += __shfl_xor(s2, 32);
                    if (fq == 0) { atomicAdd(avstat + 2 * row, s1); atomicAdd(avstat + 2 * row + 1, s2); } }
#pragma unroll
                for (int bj = 0; bj < 2; ++bj) { const f32x4 v0 = v[bj][0], v1 = v[bj][1];
                    u32x4 w; w.x = cvt_pk_bf16(v0[0], v0[1]); w.y = cvt_pk_bf16(v0[2], v0[3]); w.z = cvt_pk_bf16(v1[0], v1[1]); w.w = cvt_pk_bf16(v1[2], v1[3]);
                    *(u32x4*)(rowp + bj * HALF) = w; } }
    }
};
struct EpiRes {
    static constexpr bool PERM = true, AFTER_DRAIN = false;
    const float* basef; bf16_t* xb; float* rss; int ldc;
    __device__ __forceinline__ void operator()(const f32x4 (&acc)[2][2][4][2], const Unit& u, int wr, int wc, int fr, int fq) const {
        const int col0 = u.pn * BM + wc * 32 + 8 * fq;
#pragma unroll
        for (int ai = 0; ai < 2; ++ai)
#pragma unroll
            for (int m = 0; m < 4; ++m) { const int r = u.pm * BM + ai * HALF + wr * 64 + m * 16 + fr; const size_t off = (size_t)r * ldc + col0; float ss = 0.f;
#pragma unroll
                for (int bj = 0; bj < 2; ++bj) { f32x4 b0, b1;
                    if (basef) { b0 = *(const f32x4*)(basef + off + bj * HALF); b1 = *(const f32x4*)(basef + off + bj * HALF + 4); }
                    else { const u32x4 wb = *(const u32x4*)(xb + off + bj * HALF);
                        b0 = (f32x4){__uint_as_float(wb.x << 16), __uint_as_float(wb.x & 0xffff0000u), __uint_as_float(wb.y << 16), __uint_as_float(wb.y & 0xffff0000u)};
                        b1 = (f32x4){__uint_as_float(wb.z << 16), __uint_as_float(wb.z & 0xffff0000u), __uint_as_float(wb.w << 16), __uint_as_float(wb.w & 0xffff0000u)}; }
                    const f32x4 o0 = b0 + acc[ai][bj][m][0], o1 = b1 + acc[ai][bj][m][1];
                    ss += ((o0[0] * o0[0] + o0[1] * o0[1]) + (o0[2] * o0[2] + o0[3] * o0[3])) + ((o1[0] * o1[0] + o1[1] * o1[1]) + (o1[2] * o1[2] + o1[3] * o1[3]));
                    u32x4 w; w.x = cvt_pk_bf16(o0[0], o0[1]); w.y = cvt_pk_bf16(o0[2], o0[3]); w.z = cvt_pk_bf16(o1[0], o1[1]); w.w = cvt_pk_bf16(o1[2], o1[3]);
                    *(u32x4*)(xb + off + bj * HALF) = w; }
                ss += __shfl_xor(ss, 16); ss += __shfl_xor(ss, 32);
                if (fq == 0) atomicAdd(rss + r, ss); }
    }
};

template <class Epi, class Sched, bool ALIGN_EPI = false, bool SP2 = false>
__device__ __forceinline__ void gemm_phase(LAS unsigned char* lds, const Gemm g, const Sched& S, const Epi& E) {
    int tid = threadIdx.x; asm volatile("" : "+v"(tid));
    const int wid = __builtin_amdgcn_readfirstlane(tid >> 6), lane = tid & 63, wr = wid >> 2, wc = wid & 3, fr = lane & 15, fq = lane >> 4;
    const int K = g.K, nt = K / BK;
    unsigned voffA[2], voffB[2];
#pragma unroll
    for (int i = 0; i < 2; ++i) { int R, C; stage_rc(tid * 16 + i * 8192, R, C); const int Rb = Epi::PERM ? ((R & ~31) + perm32(R & 31)) : R;
        voffA[i] = (unsigned)(R * K + C) * 2u; voffB[i] = (unsigned)(Rb * K + C) * 2u; }
    const size_t kstep = (size_t)(BK * 2);
    const size_t hstep = (size_t)HALF * K * 2;
    const size_t tstep = 2 * hstep;
    const unsigned ldsw = (unsigned)wid * 1024u;
    const int aoff = lds_byte(wr * 64 + fr, fq * 8), boff = lds_byte(wc * 32 + fr, fq * 8);
#define PG8_SA(b, h) (((b) * 2 + (h)) * HTB)
#define PG8_SB(b, h) ((4 + (b) * 2 + (h)) * HTB)
#define PG8_STAGE(bufoff, gbase, voff) do { _Pragma("unroll") for (int _i = 0; _i < 2; ++_i) \
        __builtin_amdgcn_global_load_lds((const unsigned*)((const char*)(gbase) + (voff)[_i]), (LAS unsigned*)(lds + (bufoff) + ldsw + _i * 8192), 16, 0, 0); } while (0)
#define PG8_LDA(dst, b, h) do { _Pragma("unroll") for (int m = 0; m < 4; ++m) _Pragma("unroll") for (int k = 0; k < 2; ++k) dst[m][k] = *(const LAS bf16x8*)(lds + PG8_SA(b, h) + aoff + m * 2048 + k * 1024); } while (0)
#define PG8_LDB(dst, b, h) do { _Pragma("unroll") for (int n = 0; n < 2; ++n) _Pragma("unroll") for (int k = 0; k < 2; ++k) dst[n][k] = *(const LAS bf16x8*)(lds + PG8_SB(b, h) + boff + n * 2048 + k * 1024); } while (0)
#define PG8_MMA(ai, bj, At, Bt) do { __builtin_amdgcn_s_setprio(1); _Pragma("unroll") for (int m = 0; m < 4; ++m) _Pragma("unroll") for (int n = 0; n < 2; ++n) _Pragma("unroll") for (int k = 0; k < 2; ++k) \
        acc[ai][bj][m][n] = __builtin_amdgcn_mfma_f32_16x16x32_bf16(Bt[n][k], At[m][k], acc[ai][bj][m][n], 0, 0, 0); __builtin_amdgcn_s_setprio(0); } while (0)
#define PG8_WAIT_V(n) asm volatile("s_waitcnt vmcnt(" #n ")" ::: "memory")
#define PG8_WAIT_L(n) asm volatile("s_waitcnt lgkmcnt(" #n ")" ::: "memory")
#define PG8_BAR __builtin_amdgcn_s_barrier()
#define PG8_SCHED __builtin_amdgcn_sched_barrier(0)
    Unit cur, nxt; int ui = 0;
    if (!S.next(0, cur)) return;
    f32x4 acc[2][2][4][2];
#pragma unroll
    for (int a = 0; a < 2; ++a)
#pragma unroll
        for (int b = 0; b < 2; ++b)
#pragma unroll
            for (int m = 0; m < 4; ++m)
#pragma unroll
                for (int n = 0; n < 2; ++n) acc[a][b][m][n] = (f32x4){0.f, 0.f, 0.f, 0.f};
    bf16x8 At[4][2], B0[2][2], B1[2][2];
    const char* cA = (const char*)g.A + (size_t)cur.pm * tstep; const char* cB = (const char*)g.Bt + (size_t)cur.pn * tstep;
    S.a_ready(cur);
    if constexpr (SP2) {
        PG8_STAGE(PG8_SB(0, 0), cB, voffB); PG8_STAGE(PG8_SB(0, 1), cB + hstep, voffB); PG8_STAGE(PG8_SA(0, 0), cA, voffA); PG8_STAGE(PG8_SA(0, 1), cA + hstep, voffA);
        if (wr == 1) PG8_BAR;
        PG8_WAIT_V(2); PG8_BAR;
        PG8_STAGE(PG8_SB(1, 0), cB + kstep, voffB); PG8_STAGE(PG8_SA(1, 0), cA + kstep, voffA); PG8_STAGE(PG8_SB(1, 1), cB + hstep + kstep, voffB);
        PG8_WAIT_V(6); PG8_BAR;
    } else {
        PG8_STAGE(PG8_SB(0, 0), cB, voffB); PG8_STAGE(PG8_SA(0, 0), cA, voffA); PG8_STAGE(PG8_SB(0, 1), cB + hstep, voffB); PG8_STAGE(PG8_SA(0, 1), cA + hstep, voffA);
        if (wr == 1) PG8_BAR;
        PG8_WAIT_V(4); PG8_BAR;
        PG8_STAGE(PG8_SB(1, 0), cB + kstep, voffB); PG8_STAGE(PG8_SA(1, 0), cA + kstep, voffA); PG8_STAGE(PG8_SB(1, 1), cB + hstep + kstep, voffB);
        PG8_WAIT_V(6); PG8_BAR;
    }
    for (;;) {
        const bool has_next = S.next(ui + 1, nxt);
        const char* nA = has_next ? (const char*)g.A + (size_t)nxt.pm * tstep : cA; const char* nB = has_next ? (const char*)g.Bt + (size_t)nxt.pn * tstep : cB;
        for (int t = 0; t < nt; t += 2) {
            const bool last = (t == nt - 2);
            const char* a1 = cA + (size_t)(t + 1) * kstep;
            const char* a2 = last ? nA : cA + (size_t)(t + 2) * kstep; const char* b2 = last ? nB : cB + (size_t)(t + 2) * kstep;
            const char* a3 = a2 + kstep; const char* b3 = b2 + kstep;
            if (last && has_next) S.a_ready(nxt);
            if constexpr (SP2) {
            PG8_LDB(B0, 0, 0); PG8_LDB(B1, 0, 1); PG8_SCHED; PG8_LDA(At, 0, 0); PG8_STAGE(PG8_SA(1, 1), a1 + hstep, voffA);
            PG8_WAIT_V(8); PG8_WAIT_L(0); PG8_BAR; PG8_MMA(0, 0, At, B0); PG8_MMA(0, 1, At, B1); PG8_BAR; PG8_SCHED;
            PG8_LDA(At, 0, 1); PG8_STAGE(PG8_SB(0, 0), b2, voffB); PG8_STAGE(PG8_SB(0, 1), b2 + hstep, voffB); PG8_STAGE(PG8_SA(0, 0), a2, voffA);
            PG8_WAIT_V(8); PG8_WAIT_L(0); PG8_BAR; PG8_MMA(1, 0, At, B0); PG8_MMA(1, 1, At, B1); PG8_BAR; PG8_SCHED;
            PG8_LDB(B0, 1, 0); PG8_LDB(B1, 1, 1); PG8_SCHED; PG8_LDA(At, 1, 0); PG8_STAGE(PG8_SA(0, 1), a2 + hstep, voffA);
            PG8_WAIT_V(8); PG8_WAIT_L(0); PG8_BAR; PG8_MMA(0, 0, At, B0); PG8_MMA(0, 1, At, B1); PG8_BAR; PG8_SCHED;
            PG8_LDA(At, 1, 1); PG8_STAGE(PG8_SB(1, 0), b3, voffB); PG8_STAGE(PG8_SB(1, 1), b3 + hstep, voffB); PG8_STAGE(PG8_SA(1, 0), a3, voffA);
            PG8_WAIT_V(8); PG8_WAIT_L(0); PG8_BAR; PG8_MMA(1, 0, At, B0); PG8_MMA(1, 1, At, B1); PG8_BAR; PG8_SCHED;
            } else {
            PG8_LDB(B0, 0, 0); PG8_SCHED; PG8_LDA(At, 0, 0); PG8_STAGE(PG8_SA(1, 1), a1 + hstep, voffA);
            PG8_WAIT_L(8); PG8_BAR; PG8_WAIT_L(0); PG8_MMA(0, 0, At, B0); PG8_BAR; PG8_SCHED;
            PG8_LDB(B1, 0, 1); PG8_STAGE(PG8_SB(0, 0), b2, voffB);
            PG8_BAR; PG8_WAIT_L(0); PG8_MMA(0, 1, At, B1); PG8_BAR;
            PG8_LDA(At, 0, 1); PG8_STAGE(PG8_SA(0, 0), a2, voffA);
            PG8_BAR; PG8_WAIT_L(0); PG8_MMA(1, 0, At, B0); PG8_BAR; PG8_SCHED;
            PG8_STAGE(PG8_SB(0, 1), b2 + hstep, voffB);
            PG8_WAIT_V(6); PG8_BAR; PG8_MMA(1, 1, At, B1); PG8_BAR;
            PG8_LDB(B0, 1, 0); PG8_SCHED; PG8_LDA(At, 1, 0); PG8_STAGE(PG8_SA(0, 1), a2 + hstep, voffA);
            PG8_WAIT_L(8); PG8_BAR; PG8_WAIT_L(0); PG8_MMA(0, 0, At, B0); PG8_BAR; PG8_SCHED;
            PG8_LDB(B1, 1, 1); PG8_STAGE(PG8_SB(1, 0), b3, voffB);
            PG8_BAR; PG8_WAIT_L(0); PG8_MMA(0, 1, At, B1); PG8_BAR;
            PG8_LDA(At, 1, 1); PG8_STAGE(PG8_SA(1, 0), a3, voffA);
            PG8_BAR; PG8_WAIT_L(0); PG8_MMA(1, 0, At, B0); PG8_BAR; PG8_SCHED;
            PG8_STAGE(PG8_SB(1, 1), b3 + hstep, voffB);
            PG8_WAIT_V(6); PG8_BAR; PG8_MMA(1, 1, At, B1); PG8_BAR;
            }
        }
        if constexpr (ALIGN_EPI) { if (wr == 0) PG8_BAR; }
        E(acc, cur, wr, wc, fr, fq); S.done(cur);
        if (!has_next) break;
#pragma unroll
        for (int a = 0; a < 2; ++a)
#pragma unroll
            for (int b = 0; b < 2; ++b)
#pragma unroll
                for (int m = 0; m < 4; ++m)
#pragma unroll
                    for (int n = 0; n < 2; ++n) acc[a][b][m][n] = (f32x4){0.f, 0.f, 0.f, 0.f};
        cur = nxt; cA = nA; cB = nB; ++ui;
        if constexpr (ALIGN_EPI) { if (wr == 1) PG8_BAR; }
    }
    PG8_WAIT_V(0);
    if constexpr (!ALIGN_EPI) { if (wr == 0) PG8_BAR; }
    PG8_BAR;
#undef PG8_SA
#undef PG8_SB
#undef PG8_STAGE
#undef PG8_LDA
#undef PG8_LDB
#undef PG8_MMA
#undef PG8_WAIT_V
#undef PG8_WAIT_L
#undef PG8_BAR
#undef PG8_SCHED
}
}

constexpr int DM = 4096, NB = 8, SEQ = 2048, MTOK = NB * SEQ, NPROJ = 12288, GW = 1024, MEMLEN = 256, MROWS = NB * MEMLEN, NKV = 2048, DEPTH = 2;
constexpr float EPS = 1e-6f;
constexpr int NWAVES = 8, NTHREADS = 512;
constexpr int C_AU = 0, C_AV = 1024, C_AG = 2048, C_BA = 3072, C_BB = 4096, C_BG = 5120, C_CQ = 6144, C_CK = 7168, C_CV = 8192, C_CG = 9216, C_MQ = 10240, C_MG = 11264;

constexpr size_t MiB = 1u << 20;
constexpr size_t WS_CTL = 0, CTL_ZERO_BYTES = 1 * MiB;
constexpr size_t WS_RSS1 = 64 * 1024, WS_RSS2 = 128 * 1024, WS_AVSTAT = 256 * 1024;
constexpr size_t WS_RSS0 = 1 * MiB;
constexpr size_t WS_WIN = 2 * MiB;
constexpr size_t WS_WOUT = WS_WIN + 192 * MiB;
constexpr size_t WS_WKV = WS_WOUT + 64 * MiB;
constexpr size_t WS_XB = WS_WKV + 32 * MiB;
constexpr size_t WS_PROJ = WS_XB + 128 * MiB;
constexpr size_t WS_Y = WS_PROJ + 384 * MiB;
constexpr size_t WS_MEMB = WS_Y + 128 * MiB;
constexpr size_t WS_KV = WS_MEMB + 16 * MiB;
constexpr size_t WS_COS = WS_KV + 8 * MiB;
constexpr size_t WS_SIN = WS_COS + 8 * MiB;
constexpr size_t WS_X1 = WS_SIN + 8 * MiB;
constexpr size_t WS_END = WS_X1 + 256 * MiB;

constexpr int LDS_MAIN = 163840 - 256, LDS_BYTES = 163840;

DI float bf2f(bf16_t v) { return __uint_as_float((unsigned)v << 16); }
DI float bflo(unsigned w) { return __uint_as_float(w << 16); }
DI float bfhi(unsigned w) { return __uint_as_float(w & 0xffff0000u); }
DI unsigned f2bf(float f) { unsigned u = __float_as_uint(f); return (u + 0x7fffu + ((u >> 16) & 1u)) >> 16; }
typedef __bf16 bf16v2 __attribute__((ext_vector_type(2)));
DI unsigned pk2(float lo, float hi) { f32x2 v = {lo, hi}; bf16v2 b = __builtin_convertvector(v, bf16v2); return __builtin_bit_cast(unsigned, b); }
DI float silu_f(float x) { return x * __builtin_amdgcn_rcpf(1.f + __expf(-x)); }
DI float sigm_f(float x) { return __builtin_amdgcn_rcpf(1.f + __expf(-x)); }
DI float wave_sum(float v) {
#pragma unroll
    for (int o = 1; o < 64; o <<= 1) v += __shfl_xor(v, o);
    return v;
}
DI void unpack8(const u32x4 w, float (&f)[8]) { f[0] = bflo(w.x); f[1] = bfhi(w.x); f[2] = bflo(w.y); f[3] = bfhi(w.y); f[4] = bflo(w.z); f[5] = bfhi(w.z); f[6] = bflo(w.w); f[7] = bfhi(w.w); }
DI u32x4 pack8f(const float (&f)[8]) { u32x4 w; w.x = pk2(f[0], f[1]); w.y = pk2(f[2], f[3]); w.z = pk2(f[4], f[5]); w.w = pk2(f[6], f[7]); return w; }
DI int crow(int reg, int h) { return (reg & 3) + 8 * (reg >> 2) + 4 * h; }
#define MFMA32(a, b, c) __builtin_amdgcn_mfma_f32_32x32x16_bf16((a), (b), (c), 0, 0, 0)

DI bf16x8 frag_row(const LAS bf16_t* img, int ld, int row0, int k0, int lane) { return *(const LAS bf16x8*)(img + (row0 + (lane & 31)) * ld + k0 + 8 * (lane >> 5)); }
DI bf16x8 frag_row_perm(const LAS bf16_t* img, int ld, int row0, int k0, int lane) {
    const LAS bf16_t* p = img + (row0 + (lane & 31)) * ld + k0 + 4 * (lane >> 5);
    const s16x4 lo = *(const LAS s16x4*)p, hi = *(const LAS s16x4*)(p + 8);
    return __builtin_shufflevector(lo, hi, 0, 1, 2, 3, 4, 5, 6, 7);
}
DI s16x4 tr16(const LAS bf16_t* p) { return __builtin_amdgcn_ds_read_tr16_b64_v4i16((LAS s16x4*)p); }
DI bf16x8 frag_tr(const LAS bf16_t* img, int ld, int k0, int x0, int lane) {
    const int h = lane >> 5, blk = (lane >> 4) & 1, q = (lane & 15) >> 2, p = lane & 3;
    const LAS bf16_t* a = img + (k0 + 8 * h + q) * ld + x0 + 16 * blk + 4 * p;
    const s16x4 lo = tr16(a), hi = tr16(a + 4 * ld);
    return __builtin_shufflevector(lo, hi, 0, 1, 2, 3, 4, 5, 6, 7);
}
DI bf16x8 frag_tr_perm(const LAS bf16_t* img, int ld, int k0, int x0, int lane) {
    const int h = lane >> 5, blk = (lane >> 4) & 1, q = (lane & 15) >> 2, p = lane & 3;
    const LAS bf16_t* a = img + (k0 + 4 * h + q) * ld + x0 + 16 * blk + 4 * p;
    const s16x4 lo = tr16(a), hi = tr16(a + 8 * ld);
    return __builtin_shufflevector(lo, hi, 0, 1, 2, 3, 4, 5, 6, 7);
}
template <int S> DI bf16x8 pack_acc(const f32x16& x) {
    u32x4 p; p.x = pk2(x[8 * S + 0], x[8 * S + 1]); p.y = pk2(x[8 * S + 2], x[8 * S + 3]); p.z = pk2(x[8 * S + 4], x[8 * S + 5]); p.w = pk2(x[8 * S + 6], x[8 * S + 7]);
    return __builtin_bit_cast(bf16x8, p);
}
DI f32x16 zero16() { f32x16 z;
#pragma unroll
    for (int i = 0; i < 16; ++i) z[i] = 0.f; return z; }

struct Params {
    const float* x; const float* mem; const int* pos; const float* norm_g; const float* w_in; const float* sgu_ng; const float* sgu_nb; const float* sgu_w; const float* sgu_b;
    const float* conv_w; const float* conv_b; const float* conv_ng; const float* conv_nb; const float* ret_ng; const float* ret_nb; const float* mem_ng; const float* w_kv; const float* w_out; const float* fin_g;
    float* out; unsigned char* ws;
};
typedef const __attribute__((address_space(4))) Params CParams;

DI void p0_item_load(const float* W, int N, int item, int lane, f32x4 (&v)[8]) {
    const int nblk = N / 32, kb = item / nblk, nb = item % nblk, k0 = 64 * kb, n0 = 32 * nb;
#pragma unroll
    for (int i = 0; i < 8; ++i) v[i] = *(const f32x4*)(W + (size_t)(k0 + (lane >> 3) + 8 * i) * N + n0 + 4 * (lane & 7));
}
DI void p0_item_store(const f32x4 (&v)[8], const float* gain, int K, int N, bf16_t* WT, LAS float* scr, int item, int lane) {
    const int nblk = N / 32, kb = item / nblk, nb = item % nblk, k0 = 64 * kb, n0 = 32 * nb;
#pragma unroll
    for (int i = 0; i < 8; ++i) { const int kk = (lane >> 3) + 8 * i; f32x4 x = v[i]; if (gain) x = x * gain[k0 + kk]; LAS float* d = scr + kk * 33 + 4 * (lane & 7); d[0] = x.x; d[1] = x.y; d[2] = x.z; d[3] = x.w; }
    asm volatile("s_waitcnt lgkmcnt(0)" ::: "memory");
    const int c = lane & 7;
#pragma unroll
    for (int j = 0; j < 4; ++j) { const int n = (lane >> 3) + 8 * j; const LAS float* s = scr + (8 * c) * 33 + n;
        u32x4 o; o.x = pk2(s[0 * 33], s[1 * 33]); o.y = pk2(s[2 * 33], s[3 * 33]); o.z = pk2(s[4 * 33], s[5 * 33]); o.w = pk2(s[6 * 33], s[7 * 33]);
        *(u32x4*)(WT + (size_t)(n0 + n) * K + k0 + 8 * c) = o; }
    asm volatile("s_waitcnt lgkmcnt(0)" ::: "memory");
}
DI void p0_matrix(const float* W, const float* gain, int K, int N, bf16_t* WT, LAS float* scr, int nitems, int gw, int NGW, int lane) {
    for (int it = gw; it < nitems; it += 4 * NGW) {
        const int it2 = it + NGW, it3 = it + 2 * NGW, it4 = it + 3 * NGW; const bool h2 = it2 < nitems, h3 = it3 < nitems, h4 = it4 < nitems;
        f32x4 va[8], vb[8], vc[8], vd[8];
        p0_item_load(W, N, it, lane, va);
        if (h2) p0_item_load(W, N, it2, lane, vb);
        if (h3) p0_item_load(W, N, it3, lane, vc);
        if (h4) p0_item_load(W, N, it4, lane, vd);
        p0_item_store(va, gain, K, N, WT, scr, it, lane);
        if (h2) p0_item_store(vb, gain, K, N, WT, scr, it2, lane);
        if (h3) p0_item_store(vc, gain, K, N, WT, scr, it3, lane);
        if (h4) p0_item_store(vd, gain, K, N, WT, scr, it4, lane);
    }
}
DI void convert_weights(CParams& P, int l, LAS unsigned char* lds, int gw, int NGW, int lane, int wave, int which = 7) {
    unsigned char* ws = P.ws;
    LAS float* scr = (LAS float*)(lds + wave * 16384);
    constexpr int I_IN = (DM / 64) * (NPROJ / 32), I_OUT = (DM / 64) * (DM / 32), I_KV = (DM / 64) * (NKV / 32);
    if (which & 1) p0_matrix(P.w_in + (size_t)l * DM * NPROJ, P.norm_g + l * DM, DM, NPROJ, (bf16_t*)(ws + WS_WIN) + (size_t)l * NPROJ * DM, scr, I_IN, gw, NGW, lane);
    if (which & 2) p0_matrix(P.w_out + (size_t)l * DM * DM, nullptr, DM, DM, (bf16_t*)(ws + WS_WOUT) + (size_t)l * DM * DM, scr, I_OUT, gw, NGW, lane);
    if (which & 4) p0_matrix(P.w_kv + (size_t)l * DM * NKV, P.mem_ng + l * DM, DM, NKV, (bf16_t*)(ws + WS_WKV) + (size_t)l * NKV * DM, scr, I_KV, gw, NGW, lane);
}
DI void prologue(CParams& P, LAS unsigned char* lds, int vcu, int G, int tid, int lane, int wave) {
    unsigned char* ws = P.ws;
    const int gw = vcu * NWAVES + wave, NGW = G * NWAVES;
    convert_weights(P, 0, lds, gw, NGW, lane, wave);
    for (int m = gw; m < MTOK + MROWS; m += NGW) {
        const bool is_x = m < MTOK; const int row = is_x ? m : m - MTOK;
        const f32x4* xr = (const f32x4*)((is_x ? P.x : P.mem) + (size_t)row * DM) + lane;
        f32x4 v[16]; float s = 0.f;
#pragma unroll
        for (int j = 0; j < 16; ++j) { v[j] = xr[64 * j]; s += (v[j].x * v[j].x + v[j].y * v[j].y) + (v[j].z * v[j].z + v[j].w * v[j].w); }
        s = wave_sum(s);
        float sc = 1.f;
        if (is_x) { if (lane == 0) ((float*)(ws + WS_RSS0))[row] = s; } else sc = rsqrtf(s * (1.f / DM) + EPS);
        u32x2* o8 = (u32x2*)((bf16_t*)(ws + (is_x ? WS_XB : WS_MEMB)) + (size_t)row * DM) + lane;
#pragma unroll
        for (int j = 0; j < 16; ++j) { u32x2 w; w.x = pk2(v[j].x * sc, v[j].y * sc); w.y = pk2(v[j].z * sc, v[j].w * sc); o8[64 * j] = w; }
    }
    float* ct = (float*)(ws + WS_COS); float* st = (float*)(ws + WS_SIN);
    for (int i = vcu * NTHREADS + tid; i < MTOK * 128; i += G * NTHREADS) {
        const int j = i & 127, row = i >> 7;
        const float inv_freq = exp2f((float)j * (-13.287712379549449f / 128.f));
        const float ang = (float)P.pos[row] * inv_freq;
        double rev = (double)ang * 0.15915494309189535; rev -= __builtin_rint(rev);
        const float rf = (float)rev;
        ct[i] = __builtin_amdgcn_cosf(rf); st[i] = __builtin_amdgcn_sinf(rf);
    }
}

DI float reduce8(const float (&v)[8], int lane) {
    const bool h5 = lane & 32, h4 = lane & 16, h3 = lane & 8;
    float a[4], b2[2];
#pragma unroll
    for (int j = 0; j < 4; ++j) { const float keep = h5 ? v[4 + j] : v[j], send = h5 ? v[j] : v[4 + j]; a[j] = keep + __shfl_xor(send, 32); }
#pragma unroll
    for (int j = 0; j < 2; ++j) { const float keep = h4 ? a[2 + j] : a[j], send = h4 ? a[j] : a[2 + j]; b2[j] = keep + __shfl_xor(send, 16); }
    const float keep = h3 ? b2[1] : b2[0], send = h3 ? b2[0] : b2[1];
    float c = keep + __shfl_xor(send, 8);
    c += __shfl_xor(c, 4); c += __shfl_xor(c, 2); c += __shfl_xor(c, 1);
    return c;
}
DI float bcast_lane(float v, int srclane) { return __uint_as_float(__builtin_amdgcn_readlane(__float_as_uint(v), srclane)); }

DI void sgu_unit(CParams& P, int l, int u, LAS unsigned char* lds, int tid_, int lane_, int wave_) {
    int tid = tid_; asm volatile("" : "+v"(tid)); const int lane = tid & 63; const int wave = __builtin_amdgcn_readfirstlane(tid >> 6);
    const int g = u & 7, n = (u >> 3) & 15, b = u >> 7;
    const bf16_t* proj = (const bf16_t*)(P.ws + WS_PROJ) + (size_t)(b * SEQ + n * 128) * NPROJ;
    bf16_t* y = (bf16_t*)(P.ws + WS_Y) + (size_t)(b * SEQ + n * 128) * DM;
    constexpr int LD = 136, LDO = 132;
    LAS bf16_t* Wm = (LAS bf16_t*)lds; LAS bf16_t* Vn = (LAS bf16_t*)(lds + 34816); LAS float* Ot = (LAS float*)(lds + 69632);
    const float* sw = P.sgu_w + ((size_t)l * 8 + g) * 128 * 128;
    f32x4 wv[8]; u32x4 vv[4]; f32x2 av[4];
#pragma unroll
    for (int i = 0; i < 8; ++i) { const int idx = tid + NTHREADS * i, t = idx >> 5, s4 = (idx & 31) * 4; wv[i] = *(const f32x4*)(sw + t * 128 + s4); }
#pragma unroll
    for (int i = 0; i < 4; ++i) { const int idx = tid + NTHREADS * i, s = idx >> 4, c8 = (idx & 15) * 8; vv[i] = *(const u32x4*)(proj + (size_t)s * NPROJ + C_AV + g * 128 + c8);
        av[i] = *(const f32x2*)((const float*)(P.ws + WS_AVSTAT) + ((size_t)l * MTOK + (size_t)(b * SEQ + n * 128 + s)) * 2); }
#pragma unroll
    for (int i = 0; i < 8; ++i) { const int idx = tid + NTHREADS * i, t = idx >> 5, s4 = (idx & 31) * 4; f32x4 w = wv[i];
        if (s4 + 0 > t) w.x = 0.f; if (s4 + 1 > t) w.y = 0.f; if (s4 + 2 > t) w.z = 0.f; if (s4 + 3 > t) w.w = 0.f;
        u32x2 o; o.x = pk2(w.x, w.y); o.y = pk2(w.z, w.w); *(LAS u32x2*)(Wm + t * LD + s4) = o; }
    const float* ng = P.sgu_ng + l * GW + g * 128; const float* nbp = P.sgu_nb + l * GW + g * 128;
#pragma unroll
    for (int i = 0; i < 4; ++i) { const int idx = tid + NTHREADS * i, s = idx >> 4, c8 = (idx & 15) * 8;
        float f[8]; unpack8(vv[i], f); const float mean = av[i].x * (1.f / GW), var = av[i].y * (1.f / GW) - mean * mean, rstd = rsqrtf(fmaxf(var, 0.f) + EPS);
        const f32x4 g0 = *(const f32x4*)(ng + c8), g1 = *(const f32x4*)(ng + c8 + 4), b0 = *(const f32x4*)(nbp + c8), b1 = *(const f32x4*)(nbp + c8 + 4);
        const float gg[8] = {g0.x, g0.y, g0.z, g0.w, g1.x, g1.y, g1.z, g1.w}, bb[8] = {b0.x, b0.y, b0.z, b0.w, b1.x, b1.y, b1.z, b1.w};
#pragma unroll
        for (int j = 0; j < 8; ++j) f[j] = (f[j] - mean) * rstd * gg[j] + bb[j];
        *(LAS u32x4*)(Vn + s * LD + c8) = pack8f(f); }
    u32x4 uu[4], gt[4];
#pragma unroll
    for (int i = 0; i < 4; ++i) { const int idx = tid + NTHREADS * i, t = idx >> 4, c8 = (idx & 15) * 8; const bf16_t* pr = proj + (size_t)t * NPROJ + g * 128 + c8;
        uu[i] = *(const u32x4*)(pr + C_AU); gt[i] = *(const u32x4*)(pr + C_AG); }
    __syncthreads();
    { const int tt = wave >> 1, ct0 = (wave & 1) * 2;
      f32x16 acc[2]; acc[0] = zero16(); acc[1] = zero16();
      for (int ks = 0; ks < 2 * (tt + 1); ++ks) { const bf16x8 a = frag_row(Wm, LD, 32 * tt, 16 * ks, lane);
#pragma unroll
          for (int j = 0; j < 2; ++j) { const bf16x8 bb = frag_tr(Vn, LD, 16 * ks, 32 * (ct0 + j), lane); acc[j] = MFMA32(a, bb, acc[j]); } }
      const int r = lane & 31, h = lane >> 5;
#pragma unroll
      for (int j = 0; j < 2; ++j)
#pragma unroll
          for (int i = 0; i < 16; ++i) Ot[(32 * tt + crow(i, h)) * LDO + 32 * (ct0 + j) + r] = acc[j][i]; }
    __syncthreads();
    const float* sb = P.sgu_b + ((size_t)l * 8 + g) * 128;
#pragma unroll
    for (int i = 0; i < 4; ++i) { const int idx = tid + NTHREADS * i, t = idx >> 4, c8 = (idx & 15) * 8;
        const f32x4 o0 = *(const LAS f32x4*)(Ot + t * LDO + c8), o1 = *(const LAS f32x4*)(Ot + t * LDO + c8 + 4); const float bt = sb[t];
        float fu[8], fg[8], o[8]; unpack8(uu[i], fu); unpack8(gt[i], fg);
        const float ov[8] = {o0.x, o0.y, o0.z, o0.w, o1.x, o1.y, o1.z, o1.w};
#pragma unroll
        for (int j = 0; j < 8; ++j) o[j] = fu[j] * (ov[j] + bt) * silu_f(fg[j]);
        *(u32x4*)(y + (size_t)t * DM + g * 128 + c8) = pack8f(o); }
    __syncthreads();
}

DI void conv_units4(CParams& P, int l, int u0, LAS unsigned char* lds, int tid_, int lane_, int wave_) {
    int tid = tid_; asm volatile("" : "+v"(tid)); const int lane = tid & 63; const int wave = __builtin_amdgcn_readfirstlane(tid >> 6);
    const int cgp = u0 & 7, stl = (u0 >> 3) & 15, b0 = u0 >> 7; const int s0 = stl * 128;
    LAS float* glu = (LAS float*)lds;
    const float* cw = P.conv_w + (size_t)l * 31 * GW + cgp * 128 + 2 * lane;
    f32x2 w[31];
    { const float* cwj = cw;
#pragma unroll
      for (int j = 0; j < 31; ++j) { w[j] = *(const f32x2*)cwj; cwj += GW; asm volatile("" : "+v"(cwj)); } }
    const f32x2 bias = *(const f32x2*)(P.conv_b + l * GW + cgp * 128 + 2 * lane);
    const f32x2 gn = *(const f32x2*)(P.conv_ng + l * GW + cgp * 128 + 2 * lane), gb = *(const f32x2*)(P.conv_nb + l * GW + cgp * 128 + 2 * lane);
    u32x4 ra[5], rb[5];
#define CONV_LOAD(bb_) do { const bf16_t* pj_ = (const bf16_t*)(P.ws + WS_PROJ) + (size_t)((bb_) * SEQ) * NPROJ; int tl_ = tid; asm volatile("" : "+v"(tl_)); \
        _Pragma("unroll") for (int i = 0; i < 5; ++i) { int idx = tl_ + NTHREADS * i; idx = idx < 158 * 16 ? idx : 158 * 16 - 1; const int sl = idx >> 4, c8 = (idx & 15) * 8; int sg = s0 - 30 + sl; sg = sg > 0 ? sg : 0; \
            const bf16_t* pr = pj_ + (size_t)sg * NPROJ + cgp * 128 + c8; ra[i] = *(const u32x4*)(pr + C_BA); rb[i] = *(const u32x4*)(pr + C_BB); } } while (0)
    CONV_LOAD(b0);
#pragma unroll 1
    for (int k = 0; k < 4; ++k) { const int b = b0 + 2 * k;
        const bf16_t* proj = (const bf16_t*)(P.ws + WS_PROJ) + (size_t)(b * SEQ) * NPROJ;
        bf16_t* y = (bf16_t*)(P.ws + WS_Y) + (size_t)(b * SEQ) * DM;
        { int ts_ = tid; asm volatile("" : "+v"(ts_));
#pragma unroll
          for (int i = 0; i < 5; ++i) { const int idx = ts_ + NTHREADS * i;
            if (idx < 158 * 16) { const int sl = idx >> 4, c8 = (idx & 15) * 8, sg = s0 - 30 + sl; float a[8], bb[8], o[8]; unpack8(ra[i], a); unpack8(rb[i], bb);
#pragma unroll
                for (int j = 0; j < 8; ++j) { o[j] = a[j] * sigm_f(bb[j]); if (sg < 0) o[j] = 0.f; }
                *(LAS f32x4*)(glu + sl * 128 + c8) = (f32x4){o[0], o[1], o[2], o[3]}; *(LAS f32x4*)(glu + sl * 128 + c8 + 4) = (f32x4){o[4], o[5], o[6], o[7]}; } } }
        if (k < 3) CONV_LOAD(b + 2);
        __syncthreads();
#pragma unroll 1
        for (int bb = 0; bb < 2; ++bb) { const int t0 = wave * 16 + bb * 8;
            int lq = lane; asm volatile("" : "+v"(lq));
            unsigned gt[8];
#pragma unroll
            for (int i = 0; i < 8; ++i) gt[i] = *(const unsigned*)(proj + (size_t)(s0 + t0 + i) * NPROJ + C_BG + cgp * 128 + 2 * lq);
            f32x2 x[38];
#pragma unroll
            for (int r = 0; r < 38; ++r) x[r] = *(const LAS f32x2*)(glu + (t0 + r) * 128 + 2 * lq);
            f32x2 acc[8];
#pragma unroll
            for (int i = 0; i < 8; ++i) { acc[i] = bias;
#pragma unroll
                for (int j = 0; j < 31; ++j) acc[i] += w[j] * x[i + j]; }
            float ps[8], pss[8];
#pragma unroll
            for (int i = 0; i < 8; ++i) { ps[i] = acc[i].x + acc[i].y; pss[i] = acc[i].x * acc[i].x + acc[i].y * acc[i].y; }
            const float S1 = reduce8(ps, lq), S2 = reduce8(pss, lq);
            const float mean_l = S1 * (1.f / 128.f), var_l = S2 * (1.f / 128.f) - mean_l * mean_l, rstd_l = rsqrtf(fmaxf(var_l, 0.f) + EPS);
#pragma unroll
            for (int i = 0; i < 8; ++i) { const float mean = bcast_lane(mean_l, 8 * i), rstd = bcast_lane(rstd_l, 8 * i);
                const float a0 = (acc[i].x - mean) * rstd * gn.x + gb.x, a1 = (acc[i].y - mean) * rstd * gn.y + gb.y;
                *(unsigned*)(y + (size_t)(s0 + t0 + i) * DM + 1024 + cgp * 128 + 2 * lq) = pk2(silu_f(a0) * silu_f(bflo(gt[i])), silu_f(a1) * silu_f(bfhi(gt[i]))); } }
        __syncthreads();
    }
#undef CONV_LOAD
}

DI void mem_unit(CParams& P, int l, int u, LAS unsigned char* lds, int tid_, int lane_, int wave_) {
    int tid = tid_; asm volatile("" : "+v"(tid)); const int lane = tid & 63; const int wave = __builtin_amdgcn_readfirstlane(tid >> 6);
    const int tt = u & 7, hh = (u >> 3) & 3, b = u >> 5;
    const bf16_t* proj = (const bf16_t*)(P.ws + WS_PROJ) + (size_t)(b * SEQ + tt * 256) * NPROJ;
    bf16_t* y = (bf16_t*)(P.ws + WS_Y) + (size_t)(b * SEQ + tt * 256) * DM;
    const bf16_t* kv = (const bf16_t*)(P.ws + WS_KV) + (size_t)(b * MEMLEN) * NKV + hh * 256;
    constexpr int LD = 136;
    LAS bf16_t* Kc = (LAS bf16_t*)lds; LAS bf16_t* Qc = (LAS bf16_t*)(lds + 69632); LAS bf16_t* Vc = (LAS bf16_t*)lds;
    f32x16 S[8];
#pragma unroll
    for (int i = 0; i < 8; ++i) S[i] = zero16();
    u32x4 ka[8], qa[8];
#define MEM_LOAD_KQ(rr) do { _Pragma("unroll") for (int i = 0; i < 8; ++i) { const int idx = tid + NTHREADS * i, m = idx >> 4, c8 = (idx & 15) * 8; \
        ka[i] = *(const u32x4*)(kv + (size_t)m * NKV + (rr) * 128 + c8); qa[i] = *(const u32x4*)(proj + (size_t)m * NPROJ + C_MQ + hh * 256 + (rr) * 128 + c8); } } while (0)
    MEM_LOAD_KQ(0);
#pragma unroll
    for (int rr = 0; rr < 2; ++rr) {
#pragma unroll
        for (int i = 0; i < 8; ++i) { const int idx = tid + NTHREADS * i, m = idx >> 4, c8 = (idx & 15) * 8; *(LAS u32x4*)(Kc + m * LD + c8) = ka[i]; *(LAS u32x4*)(Qc + m * LD + c8) = qa[i]; }
        if (rr == 0) MEM_LOAD_KQ(1);
        __syncthreads();
#pragma unroll
        for (int ks = 0; ks < 8; ++ks) { const bf16x8 bq = frag_row(Qc, LD, 32 * wave, 16 * ks, lane);
#pragma unroll
            for (int mt = 0; mt < 8; ++mt) { const bf16x8 a = frag_row(Kc, LD, 32 * mt, 16 * ks, lane); S[mt] = MFMA32(a, bq, S[mt]); } }
        __syncthreads();
    }
#undef MEM_LOAD_KQ
    u32x4 va[8];
#define MEM_LOAD_V(rr) do { _Pragma("unroll") for (int i = 0; i < 8; ++i) { const int idx = tid + NTHREADS * i, m = idx >> 4, c8 = (idx & 15) * 8; \
        va[i] = *(const u32x4*)(kv + (size_t)m * NKV + 1024 + (rr) * 128 + c8); } } while (0)
    MEM_LOAD_V(0);
    float mx = -3.0e38f;
#pragma unroll
    for (int mt = 0; mt < 8; ++mt)
#pragma unroll
        for (int i = 0; i < 16; ++i) mx = fmaxf(mx, S[mt][i]);
    mx = fmaxf(mx, __shfl_xor(mx, 32));
    const float cs = 1.4426950408889634f * 0.0625f; float sum = 0.f;
#pragma unroll
    for (int mt = 0; mt < 8; ++mt)
#pragma unroll
        for (int i = 0; i < 16; ++i) { const float p = exp2f((S[mt][i] - mx) * cs); S[mt][i] = p; sum += p; }
    sum += __shfl_xor(sum, 32);
    const float inv = 1.f / sum;
    bf16x8 Pk[8][2];
#pragma unroll
    for (int mt = 0; mt < 8; ++mt) { Pk[mt][0] = pack_acc<0>(S[mt]); Pk[mt][1] = pack_acc<1>(S[mt]); }
    const int r = lane & 31, h = lane >> 5; const int t = 32 * wave + r;
#pragma unroll
    for (int rr = 0; rr < 2; ++rr) {
#pragma unroll
        for (int i = 0; i < 8; ++i) { const int idx = tid + NTHREADS * i, m = idx >> 4, c8 = (idx & 15) * 8; *(LAS u32x4*)(Vc + m * LD + c8) = va[i]; }
        if (rr == 0) MEM_LOAD_V(1);
        u32x2 gw[4][4];
#pragma unroll
        for (int dt = 0; dt < 2; ++dt)
#pragma unroll
            for (int g4 = 0; g4 < 4; ++g4) gw[dt][g4] = *(const u32x2*)(proj + (size_t)t * NPROJ + C_MG + hh * 256 + rr * 128 + 32 * dt + 8 * g4 + 4 * h);
        __syncthreads();
        f32x16 O[4];
#pragma unroll
        for (int dt = 0; dt < 4; ++dt) O[dt] = zero16();
#pragma unroll
        for (int mt = 0; mt < 8; ++mt) { int ln = lane; asm volatile("" : "+v"(ln));
#pragma unroll
            for (int sx = 0; sx < 2; ++sx)
#pragma unroll
                for (int dt = 0; dt < 4; ++dt) { const bf16x8 a = frag_tr_perm(Vc, LD, 32 * mt + 16 * sx, 32 * dt, ln); O[dt] = MFMA32(a, Pk[mt][sx], O[dt]); }
            asm volatile("" : "+v"(O[0]), "+v"(O[1]), "+v"(O[2]), "+v"(O[3])); }
#pragma unroll
        for (int dt = 2; dt < 4; ++dt)
#pragma unroll
            for (int g4 = 0; g4 < 4; ++g4) gw[dt][g4] = *(const u32x2*)(proj + (size_t)t * NPROJ + C_MG + hh * 256 + rr * 128 + 32 * dt + 8 * g4 + 4 * h);
#pragma unroll
        for (int dt = 0; dt < 4; ++dt)
#pragma unroll
            for (int g4 = 0; g4 < 4; ++g4) { const int d = hh * 256 + rr * 128 + 32 * dt + 8 * g4 + 4 * h; const u32x2 gq = gw[dt][g4];
                const float o0 = O[dt][4 * g4 + 0] * inv * silu_f(bflo(gq.x)), o1 = O[dt][4 * g4 + 1] * inv * silu_f(bfhi(gq.x)), o2 = O[dt][4 * g4 + 2] * inv * silu_f(bflo(gq.y)), o3 = O[dt][4 * g4 + 3] * inv * silu_f(bfhi(gq.y));
                u32x2 w; w.x = pk2(o0, o1); w.y = pk2(o2, o3); *(u32x2*)(y + (size_t)t * DM + 3072 + d) = w; }
        __syncthreads();
    }
#undef MEM_LOAD_V
}

DI void ret_unit(CParams& P, int l, int u, LAS unsigned char* lds, int tid_, int lane_, int wave_) {
    int tid0 = tid_; asm volatile("" : "+v"(tid0)); const int wave = __builtin_amdgcn_readfirstlane(tid0 >> 6);
#define RET_FRESH() int tid = tid0; asm volatile("" : "+v"(tid)); const int lane = tid & 63, r = lane & 31, h = lane >> 5; (void)r; (void)h; (void)tid
    const int hh = u & 3, b = u >> 2;
    constexpr int LD = 264, LDP = 72, LDR = 256, IMG = 33792;
    LAS bf16_t* Qs = (LAS bf16_t*)lds; LAS bf16_t* Ks = (LAS bf16_t*)(lds + IMG); LAS bf16_t* Vs = (LAS bf16_t*)(lds + 2 * IMG);
    LAS bf16_t* Ps = (LAS bf16_t*)(lds + 3 * IMG); LAS bf16_t* R = (LAS bf16_t*)(lds + 3 * IMG + 9216);
    const float g64 = exp2f(64.f * log2f(1.f - exp2f(-5.f - (float)hh)));
    const float* ng = P.ret_ng + l * GW + hh * 256; const float* nbp = P.ret_nb + l * GW + hh * 256;
    f32x16 St[8];
#pragma unroll
    for (int i = 0; i < 8; ++i) St[i] = zero16();
#define RET_DMA(img, nn) do { const char* pj_ = (const char*)((const bf16_t*)(P.ws + WS_PROJ) + (size_t)(b * SEQ + (nn) * 64) * NPROJ + hh * 256 + ((img) == 0 ? C_CQ : ((img) == 1 ? C_CK : C_CV))); \
        _Pragma("unroll 1") for (int j = wave; j < 33; j += 8) { const int q = 64 * j + lane, row = q / 33, ch = q - row * 33; \
            const char* src = pj_ + (size_t)row * (NPROJ * 2) + (ch < 32 ? ch : 31) * 16; \
            __builtin_amdgcn_global_load_lds((const unsigned*)src, (LAS unsigned*)(lds + (img) * IMG + j * 1024), 16, 0, 0); } } while (0)
#define RET_VMWAIT() asm volatile("s_waitcnt vmcnt(0)" ::: "memory")
    { RET_FRESH(); RET_DMA(0, 0); RET_DMA(1, 0); RET_DMA(2, 0); }
    RET_VMWAIT();
    __syncthreads();
    for (int n = 0; n < 32; ++n) {
        const int rowbase = b * SEQ + n * 64;
        const bf16_t* proj = (const bf16_t*)(P.ws + WS_PROJ) + (size_t)rowbase * NPROJ;
        bf16_t* y = (bf16_t*)(P.ws + WS_Y) + (size_t)rowbase * DM;
        f32x16 C[2]; C[0] = zero16(); C[1] = zero16();
        u32x2 gate[8];
        {
        RET_FRESH();
#pragma unroll
        for (int dt = 0; dt < 8; ++dt) {
            int ln = lane; asm volatile("" : "+v"(ln));
            { const bf16x8 bS = pack_acc<0>(St[dt]);
#pragma unroll
              for (int ti = 0; ti < 2; ++ti) { const bf16x8 a = frag_row_perm(Qs, LD, 32 * ti, 32 * dt, ln); C[ti] = MFMA32(a, bS, C[ti]); } }
            { const bf16x8 bS = pack_acc<1>(St[dt]);
#pragma unroll
              for (int ti = 0; ti < 2; ++ti) { const bf16x8 a = frag_row_perm(Qs, LD, 32 * ti, 32 * dt + 16, ln); C[ti] = MFMA32(a, bS, C[ti]); } }
            asm volatile("" : "+v"(C[0]), "+v"(C[1]));
        }
#pragma unroll
        for (int ti = 0; ti < 2; ++ti)
#pragma unroll
            for (int i = 0; i < 16; ++i) C[ti][i] *= g64;
        }
        RET_VMWAIT();
        __syncthreads();
        if (wave < 4) { RET_FRESH(); const int ti = wave >> 1, si = wave & 1;
          f32x16 acc = zero16();
          if (si <= ti) {
#pragma unroll
              for (int ks = 0; ks < 16; ++ks) { const bf16x8 a = frag_row(Qs, LD, 32 * ti, 16 * ks, lane), bb = frag_row(Ks, LD, 32 * si, 16 * ks, lane); acc = MFMA32(a, bb, acc); } }
#pragma unroll
          for (int i = 0; i < 16; ++i) { const int t = 32 * ti + crow(i, h), s = 32 * si + r; float v = acc[i]; if (s > t) v = 0.f; Ps[t * LDP + s] = (bf16_t)f2bf(v); } }
        __syncthreads();
        {
        RET_FRESH();
        if (n + 1 < 32) RET_DMA(0, n + 1);
        bf16x8 bv[4];
#pragma unroll
        for (int ks = 0; ks < 4; ++ks) { bv[ks] = frag_tr(Vs, LD, 16 * ks, 32 * wave, lane);
#pragma unroll
            for (int ti = 0; ti < 2; ++ti) { const bf16x8 a = frag_row(Ps, LDP, 32 * ti, 16 * ks, lane); C[ti] = MFMA32(a, bv[ks], C[ti]); } }
#pragma unroll
        for (int ti = 0; ti < 2; ++ti)
#pragma unroll
            for (int i = 0; i < 16; ++i) R[(32 * ti + crow(i, h)) * LDR + 32 * wave + r] = (bf16_t)f2bf(C[ti][i]);
        asm volatile("" ::: "memory");
#pragma unroll
        for (int i = 0; i < 8; ++i) gate[i] = *(const u32x2*)(proj + (size_t)(wave * 8 + i) * NPROJ + C_CG + hh * 256 + 4 * lane);
#pragma unroll
        for (int dt = 0; dt < 8; ++dt) {
            int ln = lane; asm volatile("" : "+v"(ln));
#pragma unroll
            for (int i = 0; i < 16; ++i) St[dt][i] *= g64;
#pragma unroll
            for (int ks = 0; ks < 4; ++ks) { const bf16x8 a = frag_tr(Ks, LD, 16 * ks, 32 * dt, ln); St[dt] = MFMA32(a, bv[ks], St[dt]); }
            asm volatile("" : "+v"(St[dt])); }
        }
        RET_VMWAIT();
        __syncthreads();
        { RET_FRESH(); if (n + 1 < 32) { RET_DMA(1, n + 1); RET_DMA(2, n + 1); } }
        {
        RET_FRESH();
        float ps[8], pss[8];
#pragma unroll
        for (int i = 0; i < 8; ++i) { const u32x2 w = *(const LAS u32x2*)(R + (wave * 8 + i) * LDR + 4 * lane); const float v0 = bflo(w.x), v1 = bfhi(w.x), v2 = bflo(w.y), v3 = bfhi(w.y);
            ps[i] = (v0 + v1) + (v2 + v3); pss[i] = (v0 * v0 + v1 * v1) + (v2 * v2 + v3 * v3); }
        const float S1 = reduce8(ps, lane), S2 = reduce8(pss, lane);
        const float mean_l = S1 * (1.f / 256.f), var_l = S2 * (1.f / 256.f) - mean_l * mean_l, rstd_l = rsqrtf(fmaxf(var_l, 0.f) + EPS);
        const f32x4 gn = *(const f32x4*)(ng + 4 * lane), gb = *(const f32x4*)(nbp + 4 * lane);
#pragma unroll
        for (int i = 0; i < 8; ++i) { const float mean = bcast_lane(mean_l, 8 * i), rstd = bcast_lane(rstd_l, 8 * i);
            const u32x2 w2 = *(const LAS u32x2*)(R + (wave * 8 + i) * LDR + 4 * lane); const float v0 = bflo(w2.x), v1 = bfhi(w2.x), v2 = bflo(w2.y), v3 = bfhi(w2.y);
            const float g0 = bflo(gate[i].x), g1 = bfhi(gate[i].x), g2 = bflo(gate[i].y), g3 = bfhi(gate[i].y);
            const float o0 = ((v0 - mean) * rstd * gn.x + gb.x) * silu_f(g0), o1 = ((v1 - mean) * rstd * gn.y + gb.y) * silu_f(g1);
            const float o2 = ((v2 - mean) * rstd * gn.z + gb.z) * silu_f(g2), o3 = ((v3 - mean) * rstd * gn.w + gb.w) * silu_f(g3);
            u32x2 w; w.x = pk2(o0, o1); w.y = pk2(o2, o3); *(u32x2*)(y + (size_t)(wave * 8 + i) * DM + 2048 + hh * 256 + 4 * lane) = w; }
        }
    }
    RET_VMWAIT();
    __syncthreads();
#undef RET_FRESH
#undef RET_DMA
#undef RET_VMWAIT
}


#define XB_TMO      128
#define XB_XCNT(j)  (256  + 64 * (j))
#define XB_XSUB(j)  (1280 + 64 * (j))
#define XB_XGEN(j)  (2304 + 64 * (j))
#define XB_TOP      3328
#define XB_TOPGEN   3392
#define XCD_BAR_WORDS 3456
#define XB_SPIN_CAP (1u << 18)
DI unsigned xb_ld(unsigned* p)              { return __hip_atomic_load(p, __ATOMIC_RELAXED, __HIP_MEMORY_SCOPE_AGENT); }
DI unsigned xb_add(unsigned* p, unsigned v) { return __hip_atomic_fetch_add(p, v, __ATOMIC_RELAXED, __HIP_MEMORY_SCOPE_AGENT); }
DI unsigned xb_xcc_id() { return (unsigned)__builtin_amdgcn_s_getreg((3 << 11) | 20) & 0xFu; }
#define XB_SPIN(cond, bar) do { unsigned _sp = 0; while (cond) { __builtin_amdgcn_s_sleep(1); \
    if ((++_sp & 255u) == 0u) { if (xb_ld(&(bar)[XB_TMO])) break; if (_sp > XB_SPIN_CAP) { atomicAdd(&(bar)[XB_TMO], 1u); break; } } } } while (0)
struct XcdBarrier { unsigned* bar; unsigned x; volatile LAS unsigned* st; };
DI XcdBarrier xcd_barrier_post(unsigned* bar, volatile LAS unsigned* st) {
    XcdBarrier b; b.bar = bar; b.x = xb_xcc_id(); b.st = st;
    if (threadIdx.x == 0) (void)xb_add(&bar[XB_XCNT(b.x)], 1u);
    return b;
}
DI void xcd_barrier_complete(unsigned* bar, unsigned x, unsigned& nloc, unsigned& nx) {
    const unsigned G = gridDim.x * gridDim.y * gridDim.z;
    unsigned sum, cnt, mine, sp = 0u;
    for (;;) {
        sum = 0u; cnt = 0u; mine = 0u;
#pragma unroll
        for (unsigned j = 0; j < 16; ++j) { const unsigned c = xb_ld(&bar[XB_XCNT(j)]); sum += c; cnt += (c > 0u) ? 1u : 0u; mine = (j == x) ? c : mine; }
        if (sum == G) break;
        __builtin_amdgcn_s_sleep(1);
        if ((++sp & 255u) == 0u) { if (xb_ld(&bar[XB_TMO])) break; if (sp > XB_SPIN_CAP) { atomicAdd(&bar[XB_TMO], 1u); break; } }
    }
    nloc = mine > 0u ? mine : 1u; nx = cnt > 0u ? cnt : 1u;
}
DI void xcd_barrier(const XcdBarrier& b) {
    asm volatile("s_waitcnt vmcnt(0)" ::: "memory");
    __syncthreads();
    if (threadIdx.x == 0) {
        unsigned* bar = b.bar; unsigned bx_ = b.x; asm volatile("" : "+s"(bx_), "+s"(bar));
        __builtin_amdgcn_s_waitcnt(0);
        unsigned nloc = b.st[0], nx = b.st[1];
        if (nloc == 0u) { xcd_barrier_complete(bar, bx_, nloc, nx); b.st[0] = nloc; b.st[1] = nx; }
        const unsigned old = xb_add(&bar[XB_XSUB(bx_)], 1u);
        const unsigned gen = old / nloc;
        if (old + 1u == (gen + 1u) * nloc) {
            __builtin_amdgcn_fence(__ATOMIC_RELEASE, "agent");
            asm volatile("s_waitcnt vmcnt(0)" ::: "memory");
            const unsigned og = xb_add(&bar[XB_TOP], 1u);
            const unsigned tg = og / nx;
            if (og + 1u == (tg + 1u) * nx) xb_add(&bar[XB_TOPGEN], 1u);
            else XB_SPIN(xb_ld(&bar[XB_TOPGEN]) == tg, bar);
            __builtin_amdgcn_fence(__ATOMIC_ACQUIRE, "agent");
            xb_add(&bar[XB_XGEN(bx_)], 1u);
            asm volatile("s_waitcnt vmcnt(0)" ::: "memory");
        } else {
            XB_SPIN(xb_ld(&bar[XB_XGEN(bx_)]) == gen, bar);
            __builtin_amdgcn_fence(__ATOMIC_ACQUIRE, "agent");
            asm volatile("s_waitcnt vmcnt(0)" ::: "memory");
        }
    }
    __syncthreads();
}

__global__ void __launch_bounds__(NTHREADS, 2) fwd_megakernel(Params P_) {
    CParams* const kp = (CParams*)__builtin_amdgcn_kernarg_segment_ptr();
#define P (*({ CParams* q_ = kp; asm volatile("" : "+s"(q_)); q_; }))
    extern __shared__ __attribute__((aligned(16))) unsigned char lds_raw[];
    cg::grid_group grid = cg::this_grid();
    LAS unsigned char* lds = (LAS unsigned char*)lds_raw;
    volatile LAS int* misc = (volatile LAS int*)(lds + LDS_MAIN);
#define tid ((int)threadIdx.x)
#define lane (tid & 63)
#define wave (__builtin_amdgcn_readfirstlane(tid >> 6))
    const int G = gridDim.x, bx = blockIdx.x; const int vcu = (G % 8 == 0) ? (bx % 8) * (G / 8) + bx / 8 : bx;
    unsigned char* ws = P.ws;
    if (tid < 16) misc[tid] = 0;
    __syncthreads();
    const XcdBarrier xbar = xcd_barrier_post((unsigned*)(ws + WS_CTL) + 4096, (volatile LAS unsigned*)(misc + 8));

#ifndef NO_PRO
    prologue(P, lds, vcu, G, tid, lane, wave);
#endif
    if (G == 0x7fffffff) grid.sync();
    xcd_barrier(xbar);

    _Pragma("unroll") for (int l = 0; l < DEPTH; ++l) {
        const float* rss_in = (const float*)(ws + (l == 0 ? WS_RSS0 : WS_RSS1));
        float* rss_out = (float*)(ws + (l == 0 ? WS_RSS1 : WS_RSS2));
        const pg8::Gemm g_in{(const bf16_t*)(ws + WS_XB), (const bf16_t*)(ws + WS_WIN) + (size_t)l * NPROJ * DM, MTOK, NPROJ, DM};
        const pg8::EpiProj E_in{(bf16_t*)(ws + WS_PROJ), NPROJ, rss_in, 1.f / DM, EPS, 1, (const float*)(ws + WS_COS), (const float*)(ws + WS_SIN), (float*)(ws + WS_AVSTAT) + (size_t)l * MTOK * 2};
        { const pg8::SubOrder S{16, 1024, 16, 24, 24, bx, G, 0};
          pg8::gemm_phase<pg8::EpiProj, pg8::SubOrder, true, true>(lds, g_in, S, E_in); }
        xcd_barrier(xbar);
#ifndef NO_RET
        if (bx < 32) ret_unit(P, l, bx, lds, tid, lane, wave);
#endif
        { const pg8::SubOrder S{32, 2048, 24, 0, 16, bx, G, 1};
          pg8::gemm_phase<pg8::EpiProj, pg8::SubOrder, true, true>(lds, g_in, S, E_in); }
        { pg8::Gemm g{(const bf16_t*)(ws + WS_MEMB), (const bf16_t*)(ws + WS_WKV) + (size_t)l * NKV * DM, MROWS, NKV, DM}; pg8::StaticOrder S; S.init(MROWS, NKV, G, (bx >= 96 && bx < 160) ? bx - 96 : (1 << 20));
          pg8::EpiProj E{(bf16_t*)(ws + WS_KV), NKV, nullptr, 0.f, 0.f, 0, nullptr, nullptr, nullptr};
          pg8::gemm_phase<pg8::EpiProj, pg8::StaticOrder, true, true>(lds, g, S, E); }
        if (bx >= 160) { int t2 = threadIdx.x; asm volatile("" : "+v"(t2)); const int w2 = __builtin_amdgcn_readfirstlane(t2 >> 6);
            convert_weights(P, 1, lds, (bx - 160) * NWAVES + w2, 96 * NWAVES, t2 & 63, w2, l == 0 ? 5 : 2); }
        xcd_barrier(xbar);
#pragma unroll 1
        for (int k = 0; k < 5; ++k) { int u = bx + 256 * (k == 0 ? 0 : (k - 1) & 3); asm volatile("" : "+s"(u));
            if (k == 0) mem_unit(P, l, u, lds, tid, lane, wave);
            else sgu_unit(P, l, u, lds, tid, lane, wave); }
        { int u = bx; asm volatile("" : "+s"(u)); conv_units4(P, l, u, lds, tid, lane, wave); }
        xcd_barrier(xbar);
        { pg8::Gemm g{(const bf16_t*)(ws + WS_Y), (const bf16_t*)(ws + WS_WOUT) + (size_t)l * DM * DM, MTOK, DM, DM}; pg8::StaticOrder S; S.init(MTOK, DM, G, bx);
          pg8::EpiRes E{l == 0 ? P.x : (const float*)nullptr, (bf16_t*)(ws + WS_XB), rss_out, DM};
          pg8::gemm_phase<pg8::EpiRes, pg8::StaticOrder, true, true>(lds, g, S, E); }
        xcd_barrier(xbar);
    }
#undef tid
#undef lane
#undef wave
    { int t2 = threadIdx.x; asm volatile("" : "+v"(t2)); const int lane = t2 & 63, wave = __builtin_amdgcn_readfirstlane(t2 >> 6);
      const int gw = vcu * NWAVES + wave, NGW = G * NWAVES; const float* rss = (const float*)(ws + WS_RSS2);
      const f32x4* gr = (const f32x4*)P.fin_g + 2 * lane; float* outp = P.out;
      for (int m = gw; m < MTOK; m += NGW) { const float rstd = rsqrtf(rss[m] * (1.f / DM) + EPS);
          const u32x4* xr = (const u32x4*)((const bf16_t*)(ws + WS_XB) + (size_t)m * DM) + lane; f32x4* orow = (f32x4*)(outp + (size_t)m * DM) + 2 * lane;
          u32x4 xv[8];
#pragma unroll
          for (int j = 0; j < 8; ++j) xv[j] = xr[64 * j];
#pragma unroll
          for (int j = 0; j < 8; ++j) { float f[8]; unpack8(xv[j], f); const f32x4 g0 = gr[128 * j], g1 = gr[128 * j + 1];
              orow[128 * j] = (f32x4){f[0], f[1], f[2], f[3]} * rstd * g0; orow[128 * j + 1] = (f32x4){f[4], f[5], f[6], f[7]} * rstd * g1; } } }
}

#undef P
extern "C" void kernel_launch(void* const* d_in, const int* in_sizes, int n_in, void* d_out, int out_size, void* d_ws, size_t ws_size, hipStream_t stream) {
    static int grid = 0;
    if (grid == 0) {
        if (n_in != 19 || in_sizes[0] != MTOK * DM || out_size != MTOK * DM || ws_size < WS_END) { fprintf(stderr, "kernel_launch: unexpected shapes (n_in %d, in0 %d, out %d, ws %zu < %zu)\n", n_in, n_in > 0 ? in_sizes[0] : -1, out_size, ws_size, (size_t)WS_END); grid = -1; return; }
        int dev = 0, cus = 0, per_cu = 0;
        if (hipGetDevice(&dev) != hipSuccess || hipDeviceGetAttribute(&cus, hipDeviceAttributeMultiprocessorCount, dev) != hipSuccess) { grid = -1; return; }
        if (hipFuncSetAttribute((const void*)fwd_megakernel, hipFuncAttributeMaxDynamicSharedMemorySize, LDS_BYTES) != hipSuccess) { fprintf(stderr, "kernel_launch: hipFuncSetAttribute failed\n"); grid = -1; return; }
        if (hipOccupancyMaxActiveBlocksPerMultiprocessor(&per_cu, (const void*)fwd_megakernel, NTHREADS, LDS_BYTES) != hipSuccess || per_cu < 1) { fprintf(stderr, "kernel_launch: occupancy query says %d\n", per_cu); per_cu = 1; }
        (void)hipGetLastError();
        grid = cus * per_cu;
        if (grid != 256) { fprintf(stderr, "kernel_launch: this kernel's phase program is laid out for a 256-workgroup grid (256 CUs x 1); got %d x %d\n", cus, per_cu); grid = -1; return; }
    }
    if (grid < 0) return;
    if (hipMemsetAsync((char*)d_ws + WS_CTL, 0, CTL_ZERO_BYTES, stream) != hipSuccess) { fprintf(stderr, "kernel_launch: memset failed\n"); return; }
    Params p{};
    p.x = (const float*)d_in[0]; p.mem = (const float*)d_in[1]; p.pos = (const int*)d_in[2]; p.norm_g = (const float*)d_in[3]; p.w_in = (const float*)d_in[4];
    p.sgu_ng = (const float*)d_in[5]; p.sgu_nb = (const float*)d_in[6]; p.sgu_w = (const float*)d_in[7]; p.sgu_b = (const float*)d_in[8];
    p.conv_w = (const float*)d_in[9]; p.conv_b = (const float*)d_in[10]; p.conv_ng = (const float*)d_in[11]; p.conv_nb = (const float*)d_in[12];
    p.ret_ng = (const float*)d_in[13]; p.ret_nb = (const float*)d_in[14]; p.mem_ng = (const float*)d_in[15]; p.w_kv = (const float*)d_in[16]; p.w_out = (const float*)d_in[17]; p.fin_g = (const float*)d_in[18];
    p.out = (float*)d_out; p.ws = (unsigned char*)d_ws;
    void* args[] = {&p};
    hipError_t e = hipLaunchCooperativeKernel((const void*)fwd_megakernel, dim3(grid), dim3(NTHREADS), args, LDS_BYTES, stream);
    if (e != hipSuccess) fprintf(stderr, "kernel_launch: cooperative launch failed: %s (grid %d)\n", hipGetErrorString(e), grid);
}
```
